# Optimizing an MI355X kernel written in HIP

```python
import math
import jax, jax.numpy as jnp
from jax import lax
import numpy as np

D_MODEL = 1024
BATCH = 4
SEQ = 8192
DEPTH = 1

CHUNK = 64
QBLOCK = 128
EPS = 1e-6

DN_HEADS = 4
DN_DK = 128
DN_DV = 128
CONV_K = 4
SA_HEADS = 4
SA_DQK = 128
SA_DV = 128
KV_RANK = 256
IDX_HEADS = 4
IDX_DIM = 64
IDX_TOPK_MAX = 256
SM_SCALE = SA_DQK ** -0.5
IDX_W_SCALE = (IDX_HEADS * IDX_DIM) ** -0.5
N_EXPERTS = 64
TOP_K = 8
N_GROUPS = 8
TOPK_GROUPS = 4
D_EXPERT = 256
D_SHARED = 256
ROUTED_SCALE = 2.5
MOE_BLOCK = 128

DN_QK = DN_HEADS * DN_DK
DN_V = DN_HEADS * DN_DV
CONV_DIM = 2 * DN_QK + DN_V
SA_Q = SA_HEADS * SA_DQK
IDX_Q = IDX_HEADS * IDX_DIM
IN_SIZES = (DN_QK, DN_QK, DN_V, DN_V, DN_HEADS, DN_HEADS, SA_Q, KV_RANK, IDX_Q, IDX_DIM, IDX_HEADS)
D_IN = 2 * DN_QK + 2 * DN_V + 2 * DN_HEADS + SA_Q + KV_RANK + IDX_Q + IDX_DIM + IDX_HEADS
MIX_WIDTH = DN_V + SA_HEADS * SA_DV

kernel_name = "hybrid_deltanet_dsa_moe_adaln_block"


def rms_norm(x, g):
    x32 = x.astype(jnp.float32)
    y = x32 * lax.rsqrt(jnp.mean(x32 * x32, axis=-1, keepdims=True) + EPS)
    return (y * g.astype(jnp.float32)).astype(x.dtype)


def layer_norm(x, g, b):
    x32 = x.astype(jnp.float32)
    mu = jnp.mean(x32, axis=-1, keepdims=True)
    xc = x32 - mu
    y = xc * lax.rsqrt(jnp.mean(xc * xc, axis=-1, keepdims=True) + EPS)
    return (y * g.astype(jnp.float32) + b.astype(jnp.float32)).astype(x.dtype)


def l2_normalize(x):
    x32 = x.astype(jnp.float32)
    return (x32 * lax.rsqrt(jnp.sum(x32 * x32, axis=-1, keepdims=True) + EPS)).astype(x.dtype)


def split_cols(a, sizes):
    offsets = []
    acc = 0
    for s in sizes[:-1]:
        acc += s
        offsets.append(acc)
    return jnp.split(a, offsets, axis=-1)


def causal_depthwise_conv(x, w):
    ch = x.shape[-1]
    return lax.conv_general_dilated(
        x, w[:, None, :].astype(x.dtype), window_strides=(1,),
        padding=[(w.shape[0] - 1, 0)], dimension_numbers=("NWC", "WIO", "NWC"),
        feature_group_count=ch)


def gated_delta_rule(q, k, v, g, beta):
    B, T, H, DK = q.shape
    DV = v.shape[-1]
    n = T // CHUNK
    f32 = jnp.float32

    def blk(a):
        a = a.astype(f32).reshape(B, n, CHUNK, H, *a.shape[3:])
        return jnp.swapaxes(a, 2, 3)

    q, k, v, g, beta = blk(q), blk(k), blk(v), blk(g), blk(beta)
    g = jnp.cumsum(g, axis=-1)
    pos = jnp.arange(CHUNK)
    causal = pos[:, None] >= pos[None, :]
    strict = pos[:, None] > pos[None, :]
    decay = jnp.exp(jnp.where(causal, g[..., :, None] - g[..., None, :], -jnp.inf))
    kb = k * beta[..., None]
    a_strict = jnp.where(strict, jnp.einsum("bnhid,bnhjd->bnhij", kb, k) * decay, 0.0)
    lhs = a_strict + jnp.eye(CHUNK, dtype=f32)
    rhs = jnp.concatenate([v * beta[..., None], kb * jnp.exp(g)[..., None]], axis=-1)
    sol = lax.linalg.triangular_solve(lhs, rhs, left_side=True, lower=True)
    u, w = sol[..., :DV], sol[..., DV:]
    qk = jnp.einsum("bnhid,bnhjd->bnhij", q, k) * decay
    q_dec = q * jnp.exp(g)[..., None]
    k_dec = k * jnp.exp(g[..., -1:] - g)[..., None]
    g_tot = jnp.exp(g[..., -1])

    def step(S, inp):
        q_c, qk_c, u_c, w_c, k_c, gt = inp
        v_new = u_c - jnp.einsum("bhcd,bhde->bhce", w_c, S)
        o = jnp.einsum("bhcd,bhde->bhce", q_c, S) + jnp.einsum("bhij,bhje->bhie", qk_c, v_new)
        S = S * gt[..., None, None] + jnp.einsum("bhcd,bhce->bhde", k_c, v_new)
        return S, o

    S0 = jnp.zeros((B, H, DK, DV), f32)
    xs = tuple(jnp.moveaxis(a, 1, 0) for a in (q_dec, qk, u, w, k_dec, g_tot))
    _, o = lax.scan(step, S0, xs)
    return jnp.swapaxes(jnp.moveaxis(o, 0, 1), 2, 3).reshape(B, T, H, DV)


def sparse_attention(q_lat, ckv, q_ix, k_ix, w_ix, topk):
    B, T, H, R = q_lat.shape
    nb = T // QBLOCK
    key_pos = jnp.arange(T)

    def to_blocks(a):
        return jnp.moveaxis(a.reshape(B, nb, QBLOCK, *a.shape[2:]), 1, 0)

    def attend_block(args):
        ql, qi, wi, start = args
        t = start + jnp.arange(QBLOCK)
        limit = (t // CHUNK + 1) * CHUNK
        admissible = key_pos[None, :] < limit[:, None]
        rel = jax.nn.relu(jnp.einsum("bqhd,bsd->bqhs", qi, k_ix))
        score = jnp.einsum("bqh,bqhs->bqs", wi, rel).astype(jnp.float32)
        score = jnp.where(admissible[None], score, -jnp.inf)
        _, idx = lax.top_k(score, topk)
        valid = idx < limit[None, :, None]
        kv = jax.vmap(lambda a, i: a[i])(ckv, idx)
        logits = jnp.einsum("bqhr,bqkr->bqhk", ql, kv).astype(jnp.float32) * SM_SCALE
        logits = jnp.where(valid[:, :, None, :], logits, -jnp.inf)
        p = jax.nn.softmax(logits, axis=-1).astype(kv.dtype)
        return jnp.einsum("bqhk,bqkr->bqhr", p, kv)

    starts = jnp.arange(nb) * QBLOCK
    out = lax.map(attend_block, (to_blocks(q_lat), to_blocks(q_ix), to_blocks(w_ix), starts))
    return jnp.moveaxis(out, 0, 1).reshape(B, T, H, R)


def token_mixers(h, w_in, conv_w, a_log, dt_bias, dn_norm_g, kv_norm_g, w_uk, w_uv,
                 idx_k_ln_g, idx_k_ln_b, topk):
    B, T, _ = h.shape
    proj = h @ w_in
    (q_dn, k_dn, v_dn, z_dn, b_dn, a_dn, q_sa, ckv, q_ix, k_ix, w_ix) = split_cols(proj, IN_SIZES)

    qkv = jax.nn.silu(causal_depthwise_conv(jnp.concatenate([q_dn, k_dn, v_dn], axis=-1), conv_w))
    q_dn, k_dn, v_dn = jnp.split(qkv, [DN_QK, 2 * DN_QK], axis=-1)
    q_dn = l2_normalize(q_dn.reshape(B, T, DN_HEADS, DN_DK)) * (DN_DK ** -0.5)
    k_dn = l2_normalize(k_dn.reshape(B, T, DN_HEADS, DN_DK))
    v_dn = v_dn.reshape(B, T, DN_HEADS, DN_DV)
    beta = jax.nn.sigmoid(b_dn.astype(jnp.float32))
    g = -jnp.exp(a_log.astype(jnp.float32)) * jax.nn.softplus(
        a_dn.astype(jnp.float32) + dt_bias.astype(jnp.float32))
    o_dn = gated_delta_rule(q_dn, k_dn, v_dn, g, beta).astype(h.dtype)
    o_dn = rms_norm(o_dn, dn_norm_g) * jax.nn.silu(z_dn.reshape(B, T, DN_HEADS, DN_DV))

    q_sa = q_sa.reshape(B, T, SA_HEADS, SA_DQK)
    ckv = rms_norm(ckv, kv_norm_g)
    q_lat = jnp.einsum("bthd,hrd->bthr", q_sa, w_uk)
    q_ix = q_ix.reshape(B, T, IDX_HEADS, IDX_DIM)
    k_ix = layer_norm(k_ix, idx_k_ln_g, idx_k_ln_b)
    w_ix = w_ix * IDX_W_SCALE
    o_lat = sparse_attention(q_lat, ckv, q_ix, k_ix, w_ix, topk)
    o_sa = jnp.einsum("bthr,hrd->bthd", o_lat, w_uv)

    return jnp.concatenate([o_dn.reshape(B, T, DN_V), o_sa.reshape(B, T, SA_HEADS * SA_DV)], axis=-1)


def moe_ffn(h, router_w, router_b, w_gate, w_up, w_down, s_gate, s_up, s_down):
    B, T, D = h.shape
    xt = h.reshape(-1, D)
    n_tok = xt.shape[0]
    scores = jax.nn.sigmoid((xt @ router_w).astype(jnp.float32))
    choice = scores + router_b.astype(jnp.float32)
    grouped = choice.reshape(n_tok, N_GROUPS, N_EXPERTS // N_GROUPS)
    group_score = jnp.sum(lax.top_k(grouped, 2)[0], axis=-1)
    _, top_groups = lax.top_k(group_score, TOPK_GROUPS)
    group_mask = jnp.any(top_groups[..., None] == jnp.arange(N_GROUPS), axis=1)
    expert_mask = jnp.repeat(group_mask, N_EXPERTS // N_GROUPS, axis=1)
    _, top_e = lax.top_k(jnp.where(expert_mask, choice, -jnp.inf), TOP_K)
    gate = jnp.take_along_axis(scores, top_e, axis=1)
    gate = gate / jnp.sum(gate, axis=-1, keepdims=True) * ROUTED_SCALE

    n_assign = n_tok * TOP_K
    flat_e = top_e.reshape(-1)
    order = jnp.argsort(flat_e)
    sorted_e = flat_e[order]
    sorted_tok = (order // TOP_K).astype(jnp.int32)
    sorted_gate = gate.reshape(-1)[order]
    counts = jnp.bincount(flat_e, length=N_EXPERTS)
    padded = (counts + MOE_BLOCK - 1) // MOE_BLOCK * MOE_BLOCK
    starts = jnp.cumsum(counts) - counts
    pad_ends = jnp.cumsum(padded)
    pad_starts = pad_ends - padded
    dest = pad_starts[sorted_e] + jnp.arange(n_assign) - starts[sorted_e]
    cap = n_assign + N_EXPERTS * MOE_BLOCK
    n_blocks = cap // MOE_BLOCK
    buf_tok = jnp.full((cap,), n_tok, jnp.int32).at[dest].set(sorted_tok)
    buf_gate = jnp.zeros((cap,), jnp.float32).at[dest].set(sorted_gate)
    blk_e = jnp.minimum(jnp.searchsorted(pad_ends, jnp.arange(n_blocks) * MOE_BLOCK, side="right"),
                        N_EXPERTS - 1)

    def expert_block(args):
        tok, gt, e = args
        xb = jnp.take(xt, tok, axis=0, mode="fill", fill_value=0)
        hb = jax.nn.silu(xb @ w_gate[e]) * (xb @ w_up[e])
        return (hb @ w_down[e]) * gt[:, None].astype(xb.dtype)

    y = lax.map(expert_block, (buf_tok.reshape(n_blocks, MOE_BLOCK),
                               buf_gate.reshape(n_blocks, MOE_BLOCK), blk_e))
    routed = jax.ops.segment_sum(y.reshape(cap, D), buf_tok, num_segments=n_tok)
    shared = (jax.nn.silu(xt @ s_gate) * (xt @ s_up)) @ s_down
    return (routed + shared).reshape(B, T, D)


def setup_inputs(seed: int = 0) -> dict:
    key = jax.random.key(seed)
    ks = jax.random.split(key, 32)
    f32 = jnp.float32
    L = DEPTH

    def nrm(k, shape, fan_in):
        return jax.random.normal(k, shape, f32) * (fan_in ** -0.5)

    def gain(k, shape):
        return 1.0 + 0.02 * jax.random.normal(k, shape, f32)

    x = jax.random.normal(ks[0], (BATCH, SEQ, D_MODEL), f32)
    c = jax.random.normal(ks[1], (BATCH, D_MODEL), f32)
    ada_w = 0.02 * jax.random.normal(ks[2], (L, D_MODEL, 6 * D_MODEL), f32)
    ada_b = 0.02 * jax.random.normal(ks[3], (L, 6 * D_MODEL), f32)
    norm1_g = gain(ks[4], (L, D_MODEL))
    w_in = nrm(ks[5], (L, D_MODEL, D_IN), D_MODEL)
    conv_w = nrm(ks[6], (L, CONV_K, CONV_DIM), CONV_K)
    a_log = jnp.log(jax.random.uniform(ks[7], (L, DN_HEADS), f32, 1.0, 16.0))
    dt = jnp.exp(jax.random.uniform(ks[8], (L, DN_HEADS), f32, math.log(1e-3), math.log(1e-1)))
    dt_bias = dt + jnp.log(-jnp.expm1(-dt))
    dn_norm_g = gain(ks[9], (L, DN_DV))
    kv_norm_g = gain(ks[10], (L, KV_RANK))
    w_uk = nrm(ks[11], (L, SA_HEADS, KV_RANK, SA_DQK), KV_RANK)
    w_uv = nrm(ks[12], (L, SA_HEADS, KV_RANK, SA_DV), KV_RANK)
    idx_k_ln_g = gain(ks[13], (L, IDX_DIM))
    idx_k_ln_b = 0.02 * jax.random.normal(ks[14], (L, IDX_DIM), f32)
    w_out = nrm(ks[15], (L, MIX_WIDTH, D_MODEL), MIX_WIDTH)
    norm2_g = gain(ks[16], (L, D_MODEL))
    router_w = nrm(ks[17], (L, D_MODEL, N_EXPERTS), D_MODEL)
    router_b = 0.01 * jax.random.normal(ks[18], (L, N_EXPERTS), f32)
    exp_w_gate = nrm(ks[19], (L, N_EXPERTS, D_MODEL, D_EXPERT), D_MODEL)
    exp_w_up = nrm(ks[20], (L, N_EXPERTS, D_MODEL, D_EXPERT), D_MODEL)
    exp_w_down = nrm(ks[21], (L, N_EXPERTS, D_EXPERT, D_MODEL), D_EXPERT)
    sh_w_gate = nrm(ks[22], (L, D_MODEL, D_SHARED), D_MODEL)
    sh_w_up = nrm(ks[23], (L, D_MODEL, D_SHARED), D_MODEL)
    sh_w_down = nrm(ks[24], (L, D_SHARED, D_MODEL), D_SHARED)
    final_g = gain(ks[25], (D_MODEL,))
    return {"x": x, "c": c, "ada_w": ada_w, "ada_b": ada_b, "norm1_g": norm1_g, "w_in": w_in,
            "conv_w": conv_w, "a_log": a_log, "dt_bias": dt_bias, "dn_norm_g": dn_norm_g,
            "kv_norm_g": kv_norm_g, "w_uk": w_uk, "w_uv": w_uv, "idx_k_ln_g": idx_k_ln_g,
            "idx_k_ln_b": idx_k_ln_b, "w_out": w_out, "norm2_g": norm2_g, "router_w": router_w,
            "router_b": router_b, "exp_w_gate": exp_w_gate, "exp_w_up": exp_w_up,
            "exp_w_down": exp_w_down, "sh_w_gate": sh_w_gate, "sh_w_up": sh_w_up,
            "sh_w_down": sh_w_down, "final_g": final_g}


def reference(x, c, ada_w, ada_b, norm1_g, w_in, conv_w, a_log, dt_bias, dn_norm_g, kv_norm_g,
              w_uk, w_uv, idx_k_ln_g, idx_k_ln_b, w_out, norm2_g, router_w, router_b,
              exp_w_gate, exp_w_up, exp_w_down, sh_w_gate, sh_w_up, sh_w_down, final_g):
    T = x.shape[1]
    topk = min(IDX_TOPK_MAX, T // 4)
    cond = jax.nn.silu(c)
    for l in range(DEPTH):
        mod = (cond @ ada_w[l] + ada_b[l])[:, None, :]
        sh1, sc1, gt1, sh2, sc2, gt2 = jnp.split(mod, 6, axis=-1)
        h = rms_norm(x, norm1_g[l]) * (1 + sc1) + sh1
        mix = token_mixers(h, w_in[l], conv_w[l], a_log[l], dt_bias[l], dn_norm_g[l], kv_norm_g[l],
                           w_uk[l], w_uv[l], idx_k_ln_g[l], idx_k_ln_b[l], topk)
        x = x + gt1 * (mix @ w_out[l])
        h = rms_norm(x, norm2_g[l]) * (1 + sc2) + sh2
        x = x + gt2 * moe_ffn(h, router_w[l], router_b[l], exp_w_gate[l], exp_w_up[l], exp_w_down[l],
                              sh_w_gate[l], sh_w_up[l], sh_w_down[l])
    return rms_norm(x, final_g)
```

```cpp
#include <hip/hip_runtime.h>
#include <cstdio>
#include <cstdint>

constexpr int NB = 4, SEQ = 8192, DM = 1024, NTOK = NB * SEQ;
constexpr int CHUNK = 64, NCH = SEQ / CHUNK;
constexpr int DIN = 3148;
constexpr int NP = 3840;
constexpr int PC_Q = 0, PC_K = 512, PC_V = 1024, PC_Z = 1536, PC_QLAT = 2048, PC_CKV = 3072, PC_QIX = 3328, PC_KIX = 3584, PC_B = 3648, PC_A = 3652, PC_WIX = 3656, PC_END = 3660;
constexpr int WC_B = 2048, WC_A = 2052, WC_QSA = 2056, WC_CKV = 2568, WC_QIX = 2824, WC_KIX = 3080, WC_WIX = 3144;
constexpr int KMIX = 1536;
constexpr int NEXP = 64, NEXP1 = 65, TOPK = 8, DEXP = 256;
constexpr int NTHREADS = 512, NWAVES = 8;
constexpr float EPS = 1e-6f;
constexpr int NASSIGN = NTOK * TOPK;
constexpr int HB_ROWS = NASSIGN + NEXP * 256 + NTOK;

typedef unsigned short bf16_t;
#define LAS __attribute__((address_space(3)))
typedef short bf16x8 __attribute__((ext_vector_type(8)));
typedef short bf16x4 __attribute__((ext_vector_type(4)));
typedef float f32x4 __attribute__((ext_vector_type(4)));
typedef float f32x2 __attribute__((ext_vector_type(2)));
typedef unsigned u32x4 __attribute__((ext_vector_type(4)));
typedef unsigned u32x2 __attribute__((ext_vector_type(2)));

constexpr size_t al256(size_t x) { return (x + 255) & ~(size_t)255; }
constexpr size_t WS_CTL    = 0;
constexpr size_t CTL_BYTES = 65536;
constexpr size_t WS_MODP   = WS_CTL + CTL_BYTES;
constexpr size_t WS_MODV   = WS_MODP + al256((size_t)8 * 4 * 6144 * 4);
constexpr size_t WS_WINT   = WS_MODV + al256((size_t)4 * 6144 * 4);
constexpr size_t WS_WOUTT  = WS_WINT + al256((size_t)NP * 1024 * 2);
constexpr size_t WS_A      = WS_WOUTT + al256((size_t)1024 * KMIX * 2);
constexpr size_t A_BYTES   = (size_t)NTOK * 1024 * 2;
constexpr size_t WS_P      = WS_A + A_BYTES;
constexpr size_t P_BYTES   = (size_t)NTOK * NP * 2;
constexpr size_t WS_C      = WS_P + P_BYTES;
constexpr size_t C_BYTES   = (size_t)118 * 1024 * 1024;
constexpr size_t WS_END    = WS_C + C_BYTES;
static_assert(WS_END <= (size_t)512 * 1024 * 1024, "workspace map exceeds 512 MiB");
constexpr size_t A_CKV  = 0;
constexpr size_t A_KIX  = A_CKV + (size_t)NTOK * 256 * 2;
constexpr size_t A_BETA = A_KIX + (size_t)NTOK * 64 * 2;
constexpr size_t A_GLOG = A_BETA + (size_t)NTOK * 4 * 4;
constexpr size_t A_WIX  = A_GLOG + (size_t)NTOK * 4 * 4;
constexpr size_t A_UT   = A_WIX + (size_t)NTOK * 4 * 4;
constexpr size_t A_GTOT = A_UT + (size_t)2048 * 128 * 64 * 2;
static_assert(A_GTOT + 2048 * 4 <= A_BYTES, "region A map");
constexpr size_t C_WM    = 0;
constexpr size_t C_QDEC  = C_WM + (size_t)2048 * 64 * 128 * 2;
constexpr size_t C_KDECT = C_QDEC + (size_t)2048 * 64 * 128 * 2;
constexpr size_t C_QK    = C_KDECT + (size_t)2048 * 64 * 128 * 2;
static_assert(C_QK + (size_t)2048 * 64 * 64 * 2 <= C_BYTES, "region C map (DeltaNet)");
constexpr size_t WS_Y    = WS_A;
constexpr size_t Y_BYTES = (size_t)HB_ROWS * 512 * 2;
constexpr size_t WS_WGU  = WS_P;
constexpr size_t WS_HB   = WS_Y + Y_BYTES;
constexpr size_t WS_WDN  = WS_HB + (size_t)HB_ROWS * 256 * 2;
constexpr size_t WS_TAB  = WS_WDN + (size_t)NEXP1 * 1024 * 256 * 2;
static_assert(WS_WGU + (size_t)NEXP1 * 512 * 1024 * 2 <= WS_HB, "gate/up weights end before HB starts");
static_assert(WS_END <= WS_WDN, "down weights / tables lie beyond every early-stage buffer");
constexpr size_t T_RTE   = 0;
constexpr size_t T_RTG   = T_RTE + (size_t)NTOK * 8 * 4;
constexpr size_t T_POS   = T_RTG + (size_t)NTOK * 8 * 4;
constexpr size_t T_STOK  = T_POS + (size_t)NTOK * 8 * 4;
constexpr size_t T_SGATE = T_STOK + (size_t)HB_ROWS * 4;
constexpr size_t T_CNT   = al256(T_SGATE + (size_t)HB_ROWS * 4);
constexpr size_t T_OFFS  = T_CNT + 64 * 256 * 4;
constexpr size_t T_TILE  = al256(T_OFFS + 64 * 257 * 4);
constexpr size_t T_META  = T_TILE + (size_t)(HB_ROWS / 256 + 1) * 4;
constexpr size_t T_END   = T_META + 64;
static_assert(WS_TAB + T_END <= (size_t)512 * 1024 * 1024, "late-stage workspace map exceeds 512 MiB");
constexpr int CW_BAR = 0;
constexpr int CW_QUEUE = 4096;
constexpr int CW_FLAG = 8192;

constexpr int LDS_MAIN = 0;
constexpr int LDS_MAIN_BYTES = 140288;
constexpr int LDS_AUX = LDS_MAIN_BYTES;
constexpr int LDS_AUX_BYTES = 6144;
constexpr int LDS_MISC = LDS_AUX + LDS_AUX_BYTES;
constexpr int LDS_BYTES = LDS_MISC + 256;
static_assert(LDS_BYTES <= 160 * 1024, "LDS");

__device__ __forceinline__ unsigned cvt_pk_bf16(float lo, float hi) { unsigned r; asm volatile("v_cvt_pk_bf16_f32 %0, %1, %2" : "=v"(r) : "v"(lo), "v"(hi)); return r; }
__device__ __forceinline__ unsigned cvt_pk_bf16_mfma(float lo, float hi) { unsigned r; asm volatile("s_nop 7\n\ts_nop 7\n\tv_cvt_pk_bf16_f32 %0, %1, %2" : "=v"(r) : "v"(lo), "v"(hi)); return r; }
__device__ __forceinline__ bf16_t f2bf(float f) { return (bf16_t)(cvt_pk_bf16(f, 0.f) & 0xffffu); }
__device__ __forceinline__ float bf2f(unsigned h) { return __uint_as_float(h << 16); }
__device__ __forceinline__ float bflo(unsigned w) { return __uint_as_float(w << 16); }
__device__ __forceinline__ float bfhi(unsigned w) { return __uint_as_float(w & 0xffff0000u); }
#define DPP_I(x, ctrl) __builtin_amdgcn_update_dpp(0, (int)(x), (ctrl), 0xf, 0xf, false)
#define DPP_F(x, ctrl) __int_as_float(__builtin_amdgcn_update_dpp(0, __float_as_int(x), (ctrl), 0xf, 0xf, false))
constexpr int DPP_XOR1 = 0xB1, DPP_XOR2 = 0x4E, DPP_HMIRROR = 0x141, DPP_MIRROR = 0x140;
__device__ __forceinline__ unsigned wave_scan_incl(unsigned v) {
    v += (unsigned)__builtin_amdgcn_update_dpp(0, (int)v, 0x111, 0xf, 0xf, false);
    v += (unsigned)__builtin_amdgcn_update_dpp(0, (int)v, 0x112, 0xf, 0xf, false);
    v += (unsigned)__builtin_amdgcn_update_dpp(0, (int)v, 0x114, 0xf, 0xf, false);
    v += (unsigned)__builtin_amdgcn_update_dpp(0, (int)v, 0x118, 0xf, 0xf, false);
    v += (unsigned)__builtin_amdgcn_update_dpp(0, (int)v, 0x142, 0xa, 0xf, false);
    v += (unsigned)__builtin_amdgcn_update_dpp(0, (int)v, 0x143, 0xc, 0xf, false);
    return v;
}
__device__ __forceinline__ float wave_scan_incl_f(float v) {
    v += __int_as_float(__builtin_amdgcn_update_dpp(0, __float_as_int(v), 0x111, 0xf, 0xf, false));
    v += __int_as_float(__builtin_amdgcn_update_dpp(0, __float_as_int(v), 0x112, 0xf, 0xf, false));
    v += __int_as_float(__builtin_amdgcn_update_dpp(0, __float_as_int(v), 0x114, 0xf, 0xf, false));
    v += __int_as_float(__builtin_amdgcn_update_dpp(0, __float_as_int(v), 0x118, 0xf, 0xf, false));
    v += __int_as_float(__builtin_amdgcn_update_dpp(0, __float_as_int(v), 0x142, 0xa, 0xf, false));
    v += __int_as_float(__builtin_amdgcn_update_dpp(0, __float_as_int(v), 0x143, 0xc, 0xf, false));
    return v;
}
__device__ __forceinline__ float oct_sum(float x) { x += DPP_F(x, DPP_XOR1); x += DPP_F(x, DPP_XOR2); x += DPP_F(x, DPP_HMIRROR); return x; }
__device__ __forceinline__ float oct_max(float x) { x = fmaxf(x, DPP_F(x, DPP_XOR1)); x = fmaxf(x, DPP_F(x, DPP_XOR2)); x = fmaxf(x, DPP_F(x, DPP_HMIRROR)); return x; }
__device__ __forceinline__ float row16_sum(float x) { x = oct_sum(x); x += DPP_F(x, DPP_MIRROR); return x; }
__device__ __forceinline__ unsigned row16_max_u(unsigned x) { unsigned t;
    t = (unsigned)DPP_I(x, DPP_XOR1); x = t > x ? t : x; t = (unsigned)DPP_I(x, DPP_XOR2); x = t > x ? t : x;
    t = (unsigned)DPP_I(x, DPP_HMIRROR); x = t > x ? t : x; t = (unsigned)DPP_I(x, DPP_MIRROR); x = t > x ? t : x; return x; }
__device__ __forceinline__ float xrow_sum(float x) {
    const auto r = __builtin_amdgcn_permlane16_swap(__float_as_uint(x), __float_as_uint(x), false, false); x = __uint_as_float(r[0]) + __uint_as_float(r[1]);
    const auto q = __builtin_amdgcn_permlane32_swap(__float_as_uint(x), __float_as_uint(x), false, false); return __uint_as_float(q[0]) + __uint_as_float(q[1]);
}
__device__ __forceinline__ float xrow_max(float x) {
    const auto r = __builtin_amdgcn_permlane16_swap(__float_as_uint(x), __float_as_uint(x), false, false); x = fmaxf(__uint_as_float(r[0]), __uint_as_float(r[1]));
    const auto q = __builtin_amdgcn_permlane32_swap(__float_as_uint(x), __float_as_uint(x), false, false); return fmaxf(__uint_as_float(q[0]), __uint_as_float(q[1]));
}
__device__ __forceinline__ float wave_sum(float v) { return xrow_sum(row16_sum(v)); }
struct GBar { LAS unsigned* cnt; unsigned target; };
__device__ __forceinline__ void gbar_sync(GBar& gb, int lane) {
    asm volatile("s_waitcnt lgkmcnt(0)" ::: "memory");
    gb.target += 4u;
    if (lane == 0) __hip_atomic_fetch_add(gb.cnt, 1u, __ATOMIC_RELAXED, __HIP_MEMORY_SCOPE_WORKGROUP);
    for (unsigned spin = 0;; ++spin) {
        const unsigned v = (unsigned)__builtin_amdgcn_readfirstlane((int)__hip_atomic_load(gb.cnt, __ATOMIC_RELAXED, __HIP_MEMORY_SCOPE_WORKGROUP));
        if ((int)(v - gb.target) >= 0 || spin > (1u << 26)) break;
        __builtin_amdgcn_s_sleep(1);
    }
    asm volatile("" ::: "memory");
}

__device__ __forceinline__ float silu_f(float x) { return x * __builtin_amdgcn_rcpf(1.0f + __expf(-x)); }
__device__ __forceinline__ float sigmoid_f(float x) { return __builtin_amdgcn_rcpf(1.0f + __expf(-x)); }

#define XB_TMO      128
#define XB_XCNT(j)  (256  + 64 * (j))
#define XB_XSUB(j)  (1280 + 64 * (j))
#define XB_XGEN(j)  (2304 + 64 * (j))
#define XB_TOP      3328
#define XB_TOPGEN   3392
#define XCD_BAR_WORDS 3456
#define XB_SPIN_CAP (1u << 18)

__device__ __forceinline__ unsigned xb_ld(unsigned* p)              { return __hip_atomic_load(p, __ATOMIC_RELAXED, __HIP_MEMORY_SCOPE_AGENT); }
__device__ __forceinline__ unsigned xb_add(unsigned* p, unsigned v) { return __hip_atomic_fetch_add(p, v, __ATOMIC_RELAXED, __HIP_MEMORY_SCOPE_AGENT); }
__device__ __forceinline__ unsigned xb_xcc_id() { return (unsigned)__builtin_amdgcn_s_getreg((3 << 11) | 20) & 0xFu; }
#define XB_SPIN(cond, bar) do { unsigned _sp = 0; while (cond) { __builtin_amdgcn_s_sleep(1); \
    if ((++_sp & 255u) == 0u) { if (xb_ld(&(bar)[XB_TMO])) break; if (_sp > XB_SPIN_CAP) { atomicAdd(&(bar)[XB_TMO], 1u); break; } } } } while (0)

struct XcdBarrier {
    unsigned* bar; unsigned x;
    volatile LAS unsigned* st;
};

__device__ __forceinline__ XcdBarrier xcd_barrier_post(unsigned* bar, volatile LAS unsigned* st) {
    XcdBarrier b; b.bar = bar; b.x = xb_xcc_id(); b.st = st;
    if (threadIdx.x == 0) (void)xb_add(&bar[XB_XCNT(b.x)], 1u);
    return b;
}
__device__ __forceinline__ void xcd_barrier_complete(unsigned* bar, unsigned x, unsigned& nloc, unsigned& nx) {
    const unsigned G = gridDim.x * gridDim.y * gridDim.z;
    unsigned sum, cnt, mine, sp = 0u;
    for (;;) {
        sum = 0u; cnt = 0u; mine = 0u;
#pragma unroll
        for (unsigned j = 0; j < 16; ++j) { const unsigned c = xb_ld(&bar[XB_XCNT(j)]); sum += c; cnt += (c > 0u) ? 1u : 0u; mine = (j == x) ? c : mine; }
        if (sum == G) break;
        __builtin_amdgcn_s_sleep(1);
        if ((++sp & 255u) == 0u) { if (xb_ld(&bar[XB_TMO])) break; if (sp > XB_SPIN_CAP) { atomicAdd(&bar[XB_TMO], 1u); break; } }
    }
    nloc = mine > 0u ? mine : 1u; nx = cnt > 0u ? cnt : 1u;
}

__device__ __forceinline__ void xcd_barrier(const XcdBarrier& b) {
    asm volatile("s_waitcnt vmcnt(0)" ::: "memory");
    __syncthreads();
    if (threadIdx.x == 0) {
        unsigned* bar = b.bar;
        __builtin_amdgcn_s_waitcnt(0);
        unsigned nloc = b.st[0], nx = b.st[1];
        if (nloc == 0u) { xcd_barrier_complete(bar, b.x, nloc, nx); b.st[0] = nloc; b.st[1] = nx; }
        const unsigned old = xb_add(&bar[XB_XSUB(b.x)], 1u);
        const unsigned gen = old / nloc;
        if (old + 1u == (gen + 1u) * nloc) {
            __builtin_amdgcn_fence(__ATOMIC_RELEASE, "agent");
            asm volatile("s_waitcnt vmcnt(0)" ::: "memory");
            const unsigned og = xb_add(&bar[XB_TOP], 1u);
            const unsigned tg = og / nx;
            if (og + 1u == (tg + 1u) * nx) xb_add(&bar[XB_TOPGEN], 1u);
            else XB_SPIN(xb_ld(&bar[XB_TOPGEN]) == tg, bar);
            __builtin_amdgcn_fence(__ATOMIC_ACQUIRE, "agent");
            xb_add(&bar[XB_XGEN(b.x)], 1u);
            asm volatile("s_waitcnt vmcnt(0)" ::: "memory");
        } else {
            XB_SPIN(xb_ld(&bar[XB_XGEN(b.x)]) == gen, bar);
            __builtin_amdgcn_fence(__ATOMIC_ACQUIRE, "agent");
            asm volatile("s_waitcnt vmcnt(0)" ::: "memory");
        }
    }
    __syncthreads();
}
namespace pg8 {
#define PG8_LAS __attribute__((address_space(3)))
constexpr int BM = 256, BK = 64, HALF = 128, HTB = HALF * BK * 2  , STAGE_BYTES = 8 * HTB, NXCD = 8, WGM = 8;

__host__ __device__ __forceinline__ int lds_byte(int r, int c) { const int st = (r >> 4) * 2 + (c >> 5), rr = r & 15, cc = c & 31, ob = rr * 64 + cc * 2; return st * 1024 + (ob ^ (((ob >> 9) & 1) << 5)); }
__host__ __device__ __forceinline__ void stage_rc(int b, int& R, int& C) { const int st = b / 1024, sb = b % 1024, swz = sb ^ (((sb >> 9) & 1) << 5); R = (st >> 1) * 16 + swz / 64; C = (st & 1) * 32 + (swz % 64) / 2; }
__host__ __device__ __forceinline__ int perm32(int rho) { const int n = rho >> 4, i = rho & 15; return 8 * (i >> 2) + 4 * n + (i & 3); }

struct Unit { int pm, pn, e; };
struct Gemm { const bf16_t* A; const bf16_t* Bt; int M, N, K, lda; };

struct StaticOrder {
    int nM, nN, nwg, G, c; const bf16_t* Bt; size_t tstepB;
    __device__ void init(int M, int N, int K, const bf16_t* Bt_, int G_, int c_) { nM = M / BM; nN = N / BM; nwg = nM * nN; G = G_; c = c_; Bt = Bt_; tstepB = (size_t)BM * K * 2; }
    __device__ bool next(int i, Unit& u) const {
        const long L = (long)i * G + c; if (L >= nwg) return false;
        int wgid = (int)L; { const int q = nwg / NXCD, r = nwg % NXCD, xcd = wgid % NXCD, off = wgid / NXCD; wgid = (xcd < r ? xcd * (q + 1) : r * (q + 1) + (xcd - r) * q) + off; }
        const int nig = WGM * nN, gid = wgid / nig, fm = gid * WGM, gsz = (nM - fm) < WGM ? (nM - fm) : WGM;
        u.pm = fm + ((wgid % nig) % gsz); u.pn = (wgid % nig) / gsz; u.e = 0; return true;
    }
    __device__ __forceinline__ const char* b_base(const Unit& u) const { return (const char*)Bt + (size_t)u.pn * tstepB; }
    __device__ __forceinline__ const int* rows(const Unit& u) const { return nullptr; }
};
struct ExpertOrder {
    const int* tile_e; const int* srows; const bf16_t* W; int n_units, G, c; size_t estep, tstepB, boff;
    __device__ bool next(int i, Unit& u) const {
        const long L = (long)i * G + c; if (L >= ((n_units + 15) & ~15)) return false;
        const int grp = (int)(L >> 4), r = (int)(L & 15); int pm = grp * 8 + (r & 7); const int ntile = n_units >> 1; pm = pm < ntile ? pm : ntile - 1;
        u.pm = pm; u.pn = r >> 3; u.e = tile_e[pm]; return true;
    }
    __device__ __forceinline__ const char* b_base(const Unit& u) const { return (const char*)W + (size_t)u.e * estep + boff + (size_t)u.pn * tstepB; }
    __device__ __forceinline__ const int* rows(const Unit& u) const { return srows + (size_t)u.pm * BM; }
};

template <class Epi, class Sched, bool GATHER>
__device__ __forceinline__ void gemm_phase(PG8_LAS unsigned char* lds, const Gemm g, const Sched& S, const Epi& E) {
    const int tid = threadIdx.x, wid = __builtin_amdgcn_readfirstlane(tid >> 6), lane = tid & 63, wr = wid >> 2, wc = wid & 3, fr = lane & 15, fq = lane >> 4;
    const int K = g.K, nt = K / BK, lda = g.lda;
    unsigned voffB[2]; int RA[2], CA[2];
#pragma unroll
    for (int i = 0; i < 2; ++i) { int R, C; stage_rc(tid * 16 + i * 8192, R, C); const int Rb = Epi::PERM ? ((R & ~31) + perm32(R & 31)) : R;
        RA[i] = R; CA[i] = C; voffB[i] = (unsigned)(Rb * K + C) * 2u; }
    const size_t kstep = (size_t)(BK * 2);
    const size_t hstepB = (size_t)HALF * K * 2;
    const size_t tstepA = (size_t)BM * lda * 2;
    const unsigned ldsw = (unsigned)wid * 1024u;
    const int aoff = lds_byte(wr * 64 + fr, fq * 8), boff = lds_byte(wc * 32 + fr, fq * 8);
#define PG8_SA(b, h) (((b) * 2 + (h)) * HTB)
#define PG8_SB(b, h) ((4 + (b) * 2 + (h)) * HTB)
#define PG8_STAGE(bufoff, gbase, voff) do { _Pragma("unroll") for (int _i = 0; _i < 2; ++_i) \
        __builtin_amdgcn_global_load_lds((const unsigned*)((const char*)(gbase) + (voff)[_i]), (PG8_LAS unsigned*)(lds + (bufoff) + ldsw + _i * 8192), 16, 0, 0); } while (0)
#define PG8_LDA(dst, b, h) do { _Pragma("unroll") for (int m = 0; m < 4; ++m) _Pragma("unroll") for (int k = 0; k < 2; ++k) dst[m][k] = *(const PG8_LAS bf16x8*)(lds + PG8_SA(b, h) + aoff + m * 2048 + k * 1024); } while (0)
#define PG8_LDB(dst, b, h) do { _Pragma("unroll") for (int n = 0; n < 2; ++n) _Pragma("unroll") for (int k = 0; k < 2; ++k) dst[n][k] = *(const PG8_LAS bf16x8*)(lds + PG8_SB(b, h) + boff + n * 2048 + k * 1024); } while (0)
#define PG8_MMA(ai, bj, At, Bt) do { __builtin_amdgcn_s_setprio(1); _Pragma("unroll") for (int m = 0; m < 4; ++m) _Pragma("unroll") for (int n = 0; n < 2; ++n) _Pragma("unroll") for (int k = 0; k < 2; ++k) \
        acc[ai][bj][m][n] = __builtin_amdgcn_mfma_f32_16x16x32_bf16(Bt[n][k], At[m][k], acc[ai][bj][m][n], 0, 0, 0); __builtin_amdgcn_s_setprio(0); } while (0)
#define PG8_WAIT_V(n) asm volatile("s_waitcnt vmcnt(" #n ")" ::: "memory")
#define PG8_WAIT_L(n) asm volatile("s_waitcnt lgkmcnt(" #n ")" ::: "memory")
#define PG8_BAR __builtin_amdgcn_s_barrier()
#define PG8_SCHED __builtin_amdgcn_sched_barrier(0)
#define PG8_AOFFS(va, u) do { if (GATHER) { const int* _rw = S.rows(u); _Pragma("unroll") for (int _h = 0; _h < 2; ++_h) _Pragma("unroll") for (int _i = 0; _i < 2; ++_i) \
            va[_h][_i] = ((unsigned)_rw[_h * HALF + RA[_i]] * (unsigned)lda + (unsigned)CA[_i]) * 2u; } \
        else { _Pragma("unroll") for (int _h = 0; _h < 2; ++_h) _Pragma("unroll") for (int _i = 0; _i < 2; ++_i) va[_h][_i] = ((unsigned)(_h * HALF + RA[_i]) * (unsigned)lda + (unsigned)CA[_i]) * 2u; } } while (0)
    Unit cur, nxt; int ui = 0;
    if (!S.next(0, cur)) return;
    f32x4 acc[2][2][4][2];
#pragma unroll
    for (int a = 0; a < 2; ++a)
#pragma unroll
        for (int b = 0; b < 2; ++b)
#pragma unroll
            for (int m = 0; m < 4; ++m)
#pragma unroll
                for (int n = 0; n < 2; ++n) acc[a][b][m][n] = (f32x4){0.f, 0.f, 0.f, 0.f};
    bf16x8 At[4][2], B0[2][2], B1[2][2];
    unsigned cva[2][2], nva[2][2];
    PG8_AOFFS(cva, cur);
    const char* cA = (const char*)g.A + (GATHER ? (size_t)0 : (size_t)cur.pm * tstepA); const char* cB = S.b_base(cur);
    PG8_STAGE(PG8_SB(0, 0), cB, voffB); PG8_STAGE(PG8_SA(0, 0), cA, cva[0]); PG8_STAGE(PG8_SB(0, 1), cB + hstepB, voffB); PG8_STAGE(PG8_SA(0, 1), cA, cva[1]);
    if (wr == 1) PG8_BAR;
    PG8_WAIT_V(4); PG8_BAR;
    PG8_STAGE(PG8_SB(1, 0), cB + kstep, voffB); PG8_STAGE(PG8_SA(1, 0), cA + kstep, cva[0]); PG8_STAGE(PG8_SB(1, 1), cB + hstepB + kstep, voffB);
    PG8_WAIT_V(6); PG8_BAR;
    for (;;) {
        const bool has_next = S.next(ui + 1, nxt);
        const char* nA = has_next ? (const char*)g.A + (GATHER ? (size_t)0 : (size_t)nxt.pm * tstepA) : cA; const char* nB = has_next ? S.b_base(nxt) : cB;
#pragma unroll
        for (int _h = 0; _h < 2; ++_h)
#pragma unroll
            for (int _i = 0; _i < 2; ++_i) nva[_h][_i] = cva[_h][_i];
        for (int t = 0; t < nt; t += 2) {
            const bool last = (t == nt - 2);
            if (GATHER && last && has_next) PG8_AOFFS(nva, nxt);
            const char* a1 = cA + (size_t)(t + 1) * kstep;
            const char* a2 = last ? nA : cA + (size_t)(t + 2) * kstep; const char* b2 = last ? nB : cB + (size_t)(t + 2) * kstep;
            const char* a3 = a2 + kstep; const char* b3 = b2 + kstep;
            unsigned va2[2][2];
#pragma unroll
            for (int _h = 0; _h < 2; ++_h)
#pragma unroll
                for (int _i = 0; _i < 2; ++_i) va2[_h][_i] = (GATHER && last) ? nva[_h][_i] : cva[_h][_i];
            PG8_LDB(B0, 0, 0); PG8_SCHED; PG8_LDA(At, 0, 0); PG8_STAGE(PG8_SA(1, 1), a1, cva[1]);
            PG8_WAIT_L(8); PG8_BAR; PG8_WAIT_L(0); PG8_MMA(0, 0, At, B0); PG8_BAR; PG8_SCHED;
            PG8_LDB(B1, 0, 1); PG8_STAGE(PG8_SB(0, 0), b2, voffB);
            PG8_BAR; PG8_WAIT_L(0); PG8_MMA(0, 1, At, B1); PG8_BAR;
            PG8_LDA(At, 0, 1); PG8_STAGE(PG8_SA(0, 0), a2, va2[0]);
            PG8_BAR; PG8_WAIT_L(0); PG8_MMA(1, 0, At, B0); PG8_BAR; PG8_SCHED;
            PG8_STAGE(PG8_SB(0, 1), b2 + hstepB, voffB);
            PG8_WAIT_V(6); PG8_BAR; PG8_MMA(1, 1, At, B1); PG8_BAR;
            PG8_LDB(B0, 1, 0); PG8_SCHED; PG8_LDA(At, 1, 0); PG8_STAGE(PG8_SA(0, 1), a2, va2[1]);
            PG8_WAIT_L(8); PG8_BAR; PG8_WAIT_L(0); PG8_MMA(0, 0, At, B0); PG8_BAR; PG8_SCHED;
            PG8_LDB(B1, 1, 1); PG8_STAGE(PG8_SB(1, 0), b3, voffB);
            PG8_BAR; PG8_WAIT_L(0); PG8_MMA(0, 1, At, B1); PG8_BAR;
            PG8_LDA(At, 1, 1); PG8_STAGE(PG8_SA(1, 0), a3, va2[0]);
            PG8_BAR; PG8_WAIT_L(0); PG8_MMA(1, 0, At, B0); PG8_BAR; PG8_SCHED;
            PG8_STAGE(PG8_SB(1, 1), b3 + hstepB, voffB);
            PG8_WAIT_V(6); PG8_BAR; PG8_MMA(1, 1, At, B1); PG8_BAR;
        }
        if (wr == 0) asm volatile("s_barrier");
        E(acc, cur, wr, wc, fr, fq);
        if (!has_next) break;
#pragma unroll
        for (int a = 0; a < 2; ++a)
#pragma unroll
            for (int b = 0; b < 2; ++b)
#pragma unroll
                for (int m = 0; m < 4; ++m)
#pragma unroll
                    for (int n = 0; n < 2; ++n) acc[a][b][m][n] = (f32x4){0.f, 0.f, 0.f, 0.f};
        cur = nxt; cA = nA; cB = nB; ++ui;
#pragma unroll
        for (int _h = 0; _h < 2; ++_h)
#pragma unroll
            for (int _i = 0; _i < 2; ++_i) cva[_h][_i] = nva[_h][_i];
        if (wr == 1) asm volatile("s_barrier");
    }
    PG8_WAIT_V(0);
    PG8_BAR;
#undef PG8_SA
#undef PG8_SB
#undef PG8_STAGE
#undef PG8_LDA
#undef PG8_LDB
#undef PG8_MMA
#undef PG8_WAIT_V
#undef PG8_WAIT_L
#undef PG8_BAR
#undef PG8_SCHED
#undef PG8_AOFFS
}

struct EpiStoreBf16 {
    static constexpr bool PERM = true;
    bf16_t* O; int ldc;
    __device__ __forceinline__ void operator()(const f32x4 (&acc)[2][2][4][2], const Unit& u, int wr, int wc, int fr, int fq) const {
        const int row0 = u.pm * BM + wr * 64 + fr, col0 = u.pn * BM + wc * 32 + 8 * fq;
#pragma unroll
        for (int ai = 0; ai < 2; ++ai)
#pragma unroll
            for (int m = 0; m < 4; ++m) { bf16_t* rowp = O + (size_t)(row0 + ai * HALF + m * 16) * ldc + col0;
#pragma unroll
                for (int bj = 0; bj < 2; ++bj) { const f32x4 v0 = acc[ai][bj][m][0], v1 = acc[ai][bj][m][1];
                    u32x4 w; w.x = cvt_pk_bf16(v0[0], v0[1]); w.y = cvt_pk_bf16(v0[2], v0[3]); w.z = cvt_pk_bf16(v1[0], v1[1]); w.w = cvt_pk_bf16(v1[2], v1[3]);
                    *(u32x4*)(rowp + bj * HALF) = w; } }
    }
};
struct EpiResidual {
    static constexpr bool PERM = false;
    const float* X; float* O; const float* gate;
    __device__ __forceinline__ void operator()(const f32x4 (&acc)[2][2][4][2], const Unit& u, int wr, int wc, int fr, int fq) const {
        const int row0 = u.pm * BM + wr * 64 + fr, col0 = u.pn * BM + wc * 32 + 4 * fq;
        const float* gp = gate + (size_t)((u.pm * BM) / SEQ) * 6144 + col0;
        f32x4 gv[2][2];
#pragma unroll
        for (int bj = 0; bj < 2; ++bj)
#pragma unroll
            for (int n = 0; n < 2; ++n) gv[bj][n] = *(const f32x4*)(gp + bj * HALF + n * 16);
#pragma unroll
        for (int ai = 0; ai < 2; ++ai)
#pragma unroll
            for (int m = 0; m < 4; ++m) { const size_t off = (size_t)(row0 + ai * HALF + m * 16) * DM + col0;
#pragma unroll
                for (int bj = 0; bj < 2; ++bj)
#pragma unroll
                    for (int n = 0; n < 2; ++n) { const f32x4 xv = *(const f32x4*)(X + off + bj * HALF + n * 16); *(f32x4*)(O + off + bj * HALF + n * 16) = xv + gv[bj][n] * acc[ai][bj][m][n]; }
                if (m == 3) asm volatile("" ::: "memory"); }
    }
};
struct EpiSwiglu {
    static constexpr bool PERM = true;
    bf16_t* HB;
    __device__ __forceinline__ void operator()(const f32x4 (&acc)[2][2][4][2], const Unit& u, int wr, int wc, int fr, int fq) const {
        const int row0 = u.pm * BM + wr * 64 + fr, col0 = u.pn * 128 + wc * 32 + 8 * fq;
#pragma unroll
        for (int ai = 0; ai < 2; ++ai)
#pragma unroll
            for (int m = 0; m < 4; ++m) { bf16_t* rowp = HB + (size_t)(row0 + ai * HALF + m * 16) * DEXP + col0;
                float h[8];
#pragma unroll
                for (int n = 0; n < 2; ++n)
#pragma unroll
                    for (int j = 0; j < 4; ++j) { const float gv = acc[ai][0][m][n][j], uv = acc[ai][1][m][n][j]; h[n * 4 + j] = gv * __builtin_amdgcn_rcpf(1.0f + __expf(-gv)) * uv; }
                u32x4 w; w.x = cvt_pk_bf16(h[0], h[1]); w.y = cvt_pk_bf16(h[2], h[3]); w.z = cvt_pk_bf16(h[4], h[5]); w.w = cvt_pk_bf16(h[6], h[7]);
                *(u32x4*)rowp = w; }
    }
};
struct EpiGateY {
    static constexpr bool PERM = true;
    bf16_t* Y; const float* sgate;
    __device__ __forceinline__ void operator()(const f32x4 (&acc)[2][2][4][2], const Unit& u, int wr, int wc, int fr, int fq) const {
        const int row0 = u.pm * BM + wr * 64 + fr, col0 = u.pn * BM + wc * 32 + 8 * fq;
#pragma unroll
        for (int ai = 0; ai < 2; ++ai)
#pragma unroll
            for (int m = 0; m < 4; ++m) { const int row = row0 + ai * HALF + m * 16; const float gv = sgate[row]; bf16_t* rowp = Y + (size_t)row * 512 + col0;
#pragma unroll
                for (int bj = 0; bj < 2; ++bj) { const f32x4 v0 = acc[ai][bj][m][0] * gv, v1 = acc[ai][bj][m][1] * gv;
                    u32x4 w; w.x = cvt_pk_bf16(v0[0], v0[1]); w.y = cvt_pk_bf16(v0[2], v0[3]); w.z = cvt_pk_bf16(v1[0], v1[1]); w.w = cvt_pk_bf16(v1[2], v1[3]);
                    *(u32x4*)(rowp + bj * HALF) = w; } }
    }
};
}

__device__ __forceinline__ void p0_mod_partials(const float* __restrict__ c, const float* __restrict__ ada_w, float* __restrict__ modp, int gwave, int nwaves, int lane) {
    for (int task = gwave; task < 768; task += nwaves) {
        const int ks = task & 7, cg = task >> 3, col = cg * 64 + lane;
        float a0 = 0.f, a1 = 0.f, a2 = 0.f, a3 = 0.f;
        for (int k = ks * 128; k < ks * 128 + 128; ++k) {
            const float w = ada_w[(size_t)k * 6144 + col];
            a0 += silu_f(c[k]) * w; a1 += silu_f(c[1024 + k]) * w; a2 += silu_f(c[2048 + k]) * w; a3 += silu_f(c[3072 + k]) * w;
        }
        modp[(size_t)(ks * 4 + 0) * 6144 + col] = a0; modp[(size_t)(ks * 4 + 1) * 6144 + col] = a1;
        modp[(size_t)(ks * 4 + 2) * 6144 + col] = a2; modp[(size_t)(ks * 4 + 3) * 6144 + col] = a3;
    }
}

template <class F>
__device__ __forceinline__ void xpose_tile(LAS float* tile, const F& f, bf16_t* dst, size_t ldd, int n0, int k0, int tid) {
    { const int nn = tid & 63, kk0 = tid >> 6;
#pragma unroll
      for (int i = 0; i < 8; ++i) { const int k = kk0 + 8 * i; tile[k * 65 + nn] = f(k0 + k, n0 + nn); } }
    __syncthreads();
    { const int kk = tid & 63, nn0 = tid >> 6;
#pragma unroll
      for (int i = 0; i < 8; ++i) { const int n = nn0 + 8 * i; dst[(size_t)(n0 + n) * ldd + k0 + kk] = f2bf(tile[kk * 65 + n]); } }
    __syncthreads();
}

struct FetchWin {
    const float* w_in;
    __device__ __forceinline__ float operator()(int k, int n) const {
        int src;
        if (n < PC_QLAT) src = n;
        else if (n < PC_B) src = n - PC_CKV + WC_CKV;
        else if (n < PC_A) src = n - PC_B + WC_B;
        else if (n < PC_WIX) src = n - PC_A + WC_A;
        else if (n < PC_END) src = n - PC_WIX + WC_WIX;
        else return 0.f;
        return w_in[(size_t)k * DIN + src];
    }
};
struct FetchPlain { const float* w; int ld; __device__ __forceinline__ float operator()(int k, int n) const { return w[(size_t)k * ld + n]; } };

constexpr int AB_S = 272, AB_IMG = 64 * AB_S;
__device__ __forceinline__ void absorb_mma(LAS unsigned char* sm, f32x4 (&acc)[2], int wave, int lane) {
    const int m = lane & 15, g = lane >> 4, mt = wave >> 1, nt0 = (wave & 1) * 2;
    acc[0] = (f32x4){0.f, 0.f, 0.f, 0.f}; acc[1] = (f32x4){0.f, 0.f, 0.f, 0.f};
#pragma unroll
    for (int ks = 0; ks < 4; ++ks) {
        const bf16x8 ahi = *(const LAS bf16x8*)(sm + (16 * mt + m) * AB_S + (32 * ks + 8 * g) * 2), alo = *(const LAS bf16x8*)(sm + AB_IMG + (16 * mt + m) * AB_S + (32 * ks + 8 * g) * 2);
#pragma unroll
        for (int t = 0; t < 2; ++t) {
            const bf16x8 bhi = *(const LAS bf16x8*)(sm + 2 * AB_IMG + (16 * (nt0 + t) + m) * AB_S + (32 * ks + 8 * g) * 2), blo = *(const LAS bf16x8*)(sm + 3 * AB_IMG + (16 * (nt0 + t) + m) * AB_S + (32 * ks + 8 * g) * 2);
            acc[t] = __builtin_amdgcn_mfma_f32_16x16x32_bf16(ahi, bhi, acc[t], 0, 0, 0);
            acc[t] = __builtin_amdgcn_mfma_f32_16x16x32_bf16(ahi, blo, acc[t], 0, 0, 0);
            acc[t] = __builtin_amdgcn_mfma_f32_16x16x32_bf16(alo, bhi, acc[t], 0, 0, 0);
        }
    }
}
__device__ __forceinline__ void absorb_put4(LAS unsigned char* img_hi, int row, int col, f32x4 v) {
    const unsigned h0 = cvt_pk_bf16(v[0], v[1]), h1 = cvt_pk_bf16(v[2], v[3]);
    const unsigned l0 = cvt_pk_bf16(v[0] - bflo(h0), v[1] - bfhi(h0)), l1 = cvt_pk_bf16(v[2] - bflo(h1), v[3] - bfhi(h1));
    *(LAS u32x2*)(img_hi + row * AB_S + col * 2) = (u32x2){h0, h1}; *(LAS u32x2*)(img_hi + AB_IMG + row * AB_S + col * 2) = (u32x2){l0, l1};
}
__device__ __forceinline__ void absorb_qlat_tile(LAS float* smf, const float* __restrict__ w_in, const float* __restrict__ w_uk, bf16_t* WinT, int item, int tid) {
    LAS unsigned char* sm = (LAS unsigned char*)smf;
    const int kt = item & 15, hr = item >> 4, h = hr >> 2, r0 = (hr & 3) * 64, k0 = kt * 64, wave = tid >> 6, lane = tid & 63;
    for (int i = tid; i < 64 * 32; i += NTHREADS) { const int r = i >> 5, d = (i & 31) * 4;
        absorb_put4(sm, r, d, *(const f32x4*)(w_uk + ((size_t)h * 256 + r0 + r) * 128 + d));
        absorb_put4(sm + 2 * AB_IMG, r, d, *(const f32x4*)(w_in + (size_t)(k0 + r) * DIN + WC_QSA + h * 128 + d)); }
    __syncthreads();
    f32x4 acc[2]; absorb_mma(sm, acc, wave, lane);
    const int m = lane & 15, g = lane >> 4, mt = wave >> 1, nt0 = (wave & 1) * 2;
#pragma unroll
    for (int t = 0; t < 2; ++t)
#pragma unroll
        for (int j = 0; j < 4; ++j) WinT[(size_t)(PC_QLAT + h * 256 + r0 + 16 * mt + 4 * g + j) * 1024 + k0 + 16 * (nt0 + t) + m] = f2bf(acc[t][j] + 0.f);
    __syncthreads();
}
__device__ __forceinline__ void absorb_uvo_tile(LAS float* smf, const float* __restrict__ w_out, const float* __restrict__ w_uv, bf16_t* WoutT, int item, int tid) {
    LAS unsigned char* sm = (LAS unsigned char*)smf;
    const int nt = item & 15, hr = item >> 4, h = hr >> 2, r0 = (hr & 3) * 64, n0 = nt * 64, wave = tid >> 6, lane = tid & 63;
    for (int i = tid; i < 64 * 32; i += NTHREADS) { const int r = i >> 5, d = (i & 31) * 4; absorb_put4(sm + 2 * AB_IMG, r, d, *(const f32x4*)(w_uv + ((size_t)h * 256 + r0 + r) * 128 + d)); }
    for (int i = tid; i < 128 * 16; i += NTHREADS) { const int d = i >> 4, n = (i & 15) * 4; const f32x4 v = *(const f32x4*)(w_out + (size_t)(512 + h * 128 + d) * 1024 + n0 + n);
#pragma unroll
        for (int j = 0; j < 4; ++j) { const bf16_t hi = f2bf(v[j]); *(LAS bf16_t*)(sm + (n + j) * AB_S + d * 2) = hi; *(LAS bf16_t*)(sm + AB_IMG + (n + j) * AB_S + d * 2) = f2bf(v[j] - bf2f(hi)); } }
    __syncthreads();
    f32x4 acc[2]; absorb_mma(sm, acc, wave, lane);
    const int m = lane & 15, g = lane >> 4, mt = wave >> 1, nt0 = (wave & 1) * 2;
#pragma unroll
    for (int t = 0; t < 2; ++t)
#pragma unroll
        for (int j = 0; j < 4; ++j) WoutT[(size_t)(n0 + 16 * mt + 4 * g + j) * KMIX + 512 + h * 256 + r0 + 16 * (nt0 + t) + m] = f2bf(acc[t][j] + 0.f);
    __syncthreads();
}

__device__ __forceinline__ void p0_weights(LAS float* sm, const float* w_in, const float* w_uk, const float* w_uv, const float* w_out, bf16_t* WinT, bf16_t* WoutT, int blk, int nblk, int tid) {
    for (int j = blk; j < 1344; j += nblk) {
        const int item = j < 256 ? 704 + j : (j < 512 ? 1088 + (j - 256) : (j < 1216 ? j - 512 : 960 + (j - 1216)));
        if (item < 704) { int nt = item >> 4; const int kt = item & 15; if (nt >= 32) nt += 16;
            FetchWin f{w_in}; xpose_tile(sm, f, WinT, 1024, nt * 64, kt * 64, tid); }
        else if (item < 960) absorb_qlat_tile(sm, w_in, w_uk, WinT, item - 704, tid);
        else if (item < 1088) { const int it = item - 960, nt = it >> 3, kt = it & 7; FetchPlain f{w_out, 1024}; xpose_tile(sm, f, WoutT, KMIX, nt * 64, kt * 64, tid); }
        else absorb_uvo_tile(sm, w_out, w_uv, WoutT, item - 1088, tid);
    }
}

__device__ __forceinline__ void xpose_tile_w(LAS unsigned char* sm, const float* __restrict__ src, size_t ld, bf16_t* __restrict__ dst, size_t ldd, int tid) {
    const int kq = (tid >> 5) * 4, c4 = (tid & 31) * 4;
    f32x4 r[4];
#pragma unroll
    for (int p = 0; p < 4; ++p) r[p] = *(const f32x4*)(src + (size_t)(kq + p) * ld + c4);
#pragma unroll
    for (int j = 0; j < 4; ++j) { u32x2 w; w.x = cvt_pk_bf16(r[0][j], r[1][j]); w.y = cvt_pk_bf16(r[2][j], r[3][j]); *(LAS u32x2*)(sm + (c4 + j) * 144 + kq * 2) = w; }
    __syncthreads();
    { const int n = tid >> 2, pc = (tid & 3) * 32;
      const u32x4 a = *(const LAS u32x4*)(sm + n * 144 + pc), b = *(const LAS u32x4*)(sm + n * 144 + pc + 16);
      bf16_t* o = dst + (size_t)n * ldd + (pc >> 1);
      *(u32x4*)o = a; *(u32x4*)(o + 8) = b; }
    __syncthreads();
}
__device__ __forceinline__ void p_expert_weights(LAS float* smf, const float* eg, const float* eu, const float* ed, const float* sg, const float* su, const float* sd, bf16_t* Wgu, bf16_t* Wdn, int blk, int nblk, int tid) {
    LAS unsigned char* sm = (LAS unsigned char*)smf;
    for (int item = blk; item < NEXP1 * 96; item += nblk) {
        const int e = item / 96, it = item % 96;
        if (it < 64) { const int nt = it >> 4, kt = it & 15, pn = nt >> 1, bj = nt & 1;
            const float* base = bj ? (e < NEXP ? eu + (size_t)e * 1024 * 256 : su) : (e < NEXP ? eg + (size_t)e * 1024 * 256 : sg);
            xpose_tile_w(sm, base + (size_t)kt * 64 * 256 + pn * 128, 256, Wgu + (size_t)e * 512 * 1024 + (size_t)nt * 128 * 1024 + kt * 64, 1024, tid); }
        else { const int i2 = it - 64, nt = i2 >> 2, kt = i2 & 3;
            const float* base = e < NEXP ? ed + (size_t)e * 256 * 1024 : sd;
            xpose_tile_w(sm, base + (size_t)kt * 64 * 1024 + nt * 128, 1024, Wdn + (size_t)e * 1024 * 256 + (size_t)nt * 128 * 256 + kt * 64, 256, tid); }
    }
}

__device__ __forceinline__ void load_mod(LAS float* dst, const float* __restrict__ modp, const float* __restrict__ ada_b, int b, int off, int n, int tid) {
    for (int j = tid; j < n; j += NTHREADS) { float s = ada_b[off + j];
#pragma unroll
        for (int ks = 0; ks < 8; ++ks) s += modp[(size_t)(ks * 4 + b) * 6144 + off + j];
        dst[j] = s; }
}
__device__ __forceinline__ void p1_norm(LAS float* sm, const float* __restrict__ x, const float* __restrict__ gain, const float* __restrict__ modp, const float* __restrict__ ada_b, int modoff, bf16_t* __restrict__ H,
                                        int blk, int nblk, int tid) {
    const int wave = tid >> 6, lane = tid & 63;
    for (int tb = blk; tb < NTOK / 128; tb += nblk) {
        const int b = (tb * 128) / SEQ;
        __syncthreads();
        load_mod(sm, modp, ada_b, b, modoff, 2048, tid);
        __syncthreads();
        for (int r0 = wave * 16; r0 < wave * 16 + 16; r0 += 4) {
            f32x4 v[4][4];
#pragma unroll
            for (int rr = 0; rr < 4; ++rr) { const float* xp = x + ((size_t)tb * 128 + r0 + rr) * DM;
#pragma unroll
                for (int i = 0; i < 4; ++i) v[rr][i] = *(const f32x4*)(xp + i * 256 + lane * 4); }
#pragma unroll
            for (int rr = 0; rr < 4; ++rr) {
                const size_t row = (size_t)tb * 128 + r0 + rr;
                float ss = 0.f;
#pragma unroll
                for (int i = 0; i < 4; ++i) ss += v[rr][i][0] * v[rr][i][0] + v[rr][i][1] * v[rr][i][1] + v[rr][i][2] * v[rr][i][2] + v[rr][i][3] * v[rr][i][3];
                ss = wave_sum(ss);
                const float rstd = rsqrtf(ss * (1.0f / DM) + EPS);
#pragma unroll
                for (int i = 0; i < 4; ++i) { const int c0 = i * 256 + lane * 4; const f32x4 gv = *(const f32x4*)(gain + c0);
                    float o[4];
#pragma unroll
                    for (int j = 0; j < 4; ++j) o[j] = v[rr][i][j] * rstd * gv[j] * (1.0f + sm[1024 + c0 + j]) + sm[c0 + j];
                    u32x2 w; w.x = cvt_pk_bf16(o[0], o[1]); w.y = cvt_pk_bf16(o[2], o[3]);
                    *(u32x2*)(H + row * DM + c0) = w; }
            }
        }
    }
}
__device__ __forceinline__ void p_final_norm(const float* __restrict__ src, float* __restrict__ dst, const float* __restrict__ gain, int gwave, int nwaves, int lane) {
    for (int row = gwave; row < NTOK; row += nwaves) {
        const float* xp = src + (size_t)row * DM;
        f32x4 v[4]; float ss = 0.f;
#pragma unroll
        for (int i = 0; i < 4; ++i) { v[i] = *(const f32x4*)(xp + i * 256 + lane * 4); ss += v[i][0] * v[i][0] + v[i][1] * v[i][1] + v[i][2] * v[i][2] + v[i][3] * v[i][3]; }
        ss = wave_sum(ss);
        const float rstd = rsqrtf(ss * (1.0f / DM) + EPS);
#pragma unroll
        for (int i = 0; i < 4; ++i) { const int c0 = i * 256 + lane * 4; const f32x4 gv = *(const f32x4*)(gain + c0);
            *(f32x4*)(dst + (size_t)row * DM + c0) = v[i] * rstd * gv; }
    }
}

__device__ __forceinline__ void p3_token_prep(const bf16_t* __restrict__ P, const float* __restrict__ kvg, const float* __restrict__ lng, const float* __restrict__ lnb,
                                              bf16_t* __restrict__ CKV, bf16_t* __restrict__ KIX, float* __restrict__ WIX, int gwave, int nwaves, int lane) {
    const f32x4 kg = *(const f32x4*)(kvg + lane * 4);
    const float g1 = lng[lane], b1 = lnb[lane];
    for (int t0 = gwave * 4; t0 < NTOK; t0 += nwaves * 4) {
        u32x2 cw[4]; unsigned short kxr[4], wxr[4];
#pragma unroll
        for (int q = 0; q < 4; ++q) { const bf16_t* pr = P + (size_t)(t0 + q) * NP; cw[q] = *(const u32x2*)(pr + PC_CKV + lane * 4); kxr[q] = pr[PC_KIX + lane]; wxr[q] = pr[PC_WIX + (lane & 3)]; }
#pragma unroll
        for (int q = 0; q < 4; ++q) {
            const int t = t0 + q;
            float v0 = bflo(cw[q].x), v1 = bfhi(cw[q].x), v2 = bflo(cw[q].y), v3 = bfhi(cw[q].y);
            const float ss = wave_sum(v0 * v0 + v1 * v1 + v2 * v2 + v3 * v3);
            const float rs = rsqrtf(ss * (1.0f / 256.0f) + EPS);
            u32x2 ow; ow.x = cvt_pk_bf16(v0 * rs * kg[0], v1 * rs * kg[1]); ow.y = cvt_pk_bf16(v2 * rs * kg[2], v3 * rs * kg[3]);
            *(u32x2*)(CKV + (size_t)t * 256 + lane * 4) = ow;
            const float kx = bf2f(kxr[q]);
            const float mu = wave_sum(kx) * (1.0f / 64.0f);
            const float xc = kx - mu;
            const float var = wave_sum(xc * xc) * (1.0f / 64.0f);
            { const int bb = t / SEQ, kk = t % SEQ;
              KIX[((size_t)bb * (SEQ / 16) + (kk >> 4)) * 1024 + (lane >> 5) * 512 + ((((lane >> 3) & 3) * 16 + (kk & 15)) * 8) + (lane & 7)] = f2bf(xc * rsqrtf(var + EPS) * g1 + b1); }
            if (lane < 4) WIX[(size_t)t * 4 + lane] = bf2f(wxr[q]) * 0.0625f;
        }
    }
}

constexpr int DN_REC_BYTES = 56 * 1024;
constexpr int DH_QN = 0;
constexpr int DH_KN = DH_QN + 64 * 136 * 2;
constexpr int DH_VB = DH_KN + 64 * 136 * 2;
constexpr int DH_AS = DH_VB + 64 * 136 * 2;
constexpr int DH_SM = DH_AS + 64 * 64 * 4;
constexpr int DH_BYTES = DH_SM + 6 * 64 * 4;
static_assert(2 * DH_BYTES <= LDS_MAIN_BYTES, "DeltaNet intra LDS");

template <class Gt>
__device__ __forceinline__ void dn_write_frags(const Gt& get, int nfrag, int nks, bf16_t* dst, int ht) {
    for (int w = ht; w < nfrag * 64; w += 256) {
        const int f = w >> 6, l = w & 63, mt = f / nks, ks = f % nks, m = l & 15, g = l >> 4;
        const int r = 16 * mt + m, c0 = 32 * ks + 4 * g;
        u32x4 o;
        o.x = cvt_pk_bf16(get(r, c0 + 0), get(r, c0 + 1)); o.y = cvt_pk_bf16(get(r, c0 + 2), get(r, c0 + 3));
        o.z = cvt_pk_bf16(get(r, c0 + 16), get(r, c0 + 17)); o.w = cvt_pk_bf16(get(r, c0 + 18), get(r, c0 + 19));
        *(u32x4*)(dst + (size_t)w * 8) = o;
    }
}

__device__ __forceinline__ void p3_dn_pair(LAS unsigned char* lds0, const bf16_t* __restrict__ P, const float* __restrict__ conv_w, const float* __restrict__ a_log, const float* __restrict__ dt_bias,
                                           unsigned char* __restrict__ regA, unsigned char* __restrict__ regC, int pair, int tid, GBar& gb) {
    const int lane = tid & 63, wave = __builtin_amdgcn_readfirstlane(tid >> 6), half = wave >> 2, hw = wave & 3, ht = tid & 255;
    const int item = 2 * pair + half;
    LAS unsigned char* lds = lds0 + half * DH_BYTES;
    const int n = item & 127, bh = item >> 7, b = bh >> 2, h = bh & 3, cid = item;
    const int t0 = b * SEQ + n * CHUNK;
    LAS bf16_t* qn = (LAS bf16_t*)(lds + DH_QN); LAS bf16_t* kn = (LAS bf16_t*)(lds + DH_KN); LAS bf16_t* vb = (LAS bf16_t*)(lds + DH_VB);
    LAS float* As = (LAS float*)(lds + DH_AS);
    LAS float* gc = (LAS float*)(lds + DH_SM); LAS float* bet = gc + 64; LAS float* eg = gc + 128; LAS float* ek = gc + 192; LAS float* rs = gc + 256;
    {
        LAS unsigned char* rawl = lds + DH_AS;
        const int cg = ht & 15, rb = ht >> 4;
        u32x4 rv[5];
#define DN_FETCH(w_) do { _Pragma("unroll") for (int q = 0; q < 5; ++q) { const int pc = ht + 256 * q; const int r = pc >> 4, c16 = pc & 15; const int tt = n * CHUNK + r - 3; \
            rv[q] = (u32x4){0u, 0u, 0u, 0u}; if (pc < 67 * 16 && tt >= 0) rv[q] = *(const u32x4*)(P + (size_t)(b * SEQ + tt) * NP + (w_) * 512 + h * 128 + c16 * 8); } } while (0)
        DN_FETCH(0);
#pragma unroll 1
        for (int which = 0; which < 3; ++which) {
            const int pcol0 = which * 512 + h * 128;
#pragma unroll
            for (int q = 0; q < 5; ++q) { const int pc = ht + 256 * q; if (pc < 67 * 16) *(LAS u32x4*)(rawl + (pc >> 4) * 256 + (pc & 15) * 16) = rv[q]; }
            if (which < 2) DN_FETCH(which + 1);
            f32x4 wlo[4], whi[4];
#pragma unroll
            for (int j = 0; j < 4; ++j) { const float* wr_ = conv_w + (size_t)j * 1536 + pcol0 + cg * 8; wlo[j] = *(const f32x4*)wr_; whi[j] = *(const f32x4*)(wr_ + 4); }
            gbar_sync(gb, lane);
            u32x4 rw_[7];
#pragma unroll
            for (int q = 0; q < 7; ++q) rw_[q] = *(const LAS u32x4*)(rawl + (4 * rb + q) * 256 + cg * 16);
            float y[4][8]; float ss[4];
#pragma unroll
            for (int rr = 0; rr < 4; ++rr) {
#pragma unroll
                for (int c = 0; c < 8; ++c) y[rr][c] = 0.f;
#pragma unroll
                for (int j = 0; j < 4; ++j) { const u32x4 r = rw_[rr + j];
                    y[rr][0] += wlo[j][0] * bflo(r.x); y[rr][1] += wlo[j][1] * bfhi(r.x); y[rr][2] += wlo[j][2] * bflo(r.y); y[rr][3] += wlo[j][3] * bfhi(r.y);
                    y[rr][4] += whi[j][0] * bflo(r.z); y[rr][5] += whi[j][1] * bfhi(r.z); y[rr][6] += whi[j][2] * bflo(r.w); y[rr][7] += whi[j][3] * bfhi(r.w); }
                ss[rr] = 0.f;
#pragma unroll
                for (int c = 0; c < 8; ++c) { y[rr][c] = silu_f(y[rr][c]); ss[rr] += y[rr][c] * y[rr][c]; }
            }
            LAS bf16_t* dstb = (which == 0 ? qn : (which == 1 ? kn : vb));
#pragma unroll
            for (int rr = 0; rr < 4; ++rr) {
                float sc = 1.0f;
                if (which < 2) { float s = row16_sum(ss[rr]); sc = rsqrtf(s + EPS) * (which == 0 ? 0.08838834764831845f : 1.0f); }
                u32x4 o; o.x = cvt_pk_bf16(y[rr][0] * sc, y[rr][1] * sc); o.y = cvt_pk_bf16(y[rr][2] * sc, y[rr][3] * sc); o.z = cvt_pk_bf16(y[rr][4] * sc, y[rr][5] * sc); o.w = cvt_pk_bf16(y[rr][6] * sc, y[rr][7] * sc);
                *(LAS u32x4*)(dstb + (4 * rb + rr) * 136 + cg * 8) = o;
            }
            gbar_sync(gb, lane);
        }
#undef DN_FETCH
    }
    if (hw == 0) {
        const bf16_t* pr = P + (size_t)(t0 + lane) * NP;
        const float bb = sigmoid_f(bf2f(pr[PC_B + h]));
        const float xa = bf2f(pr[PC_A + h]) + dt_bias[h];
        const float sp = xa > 20.f ? xa : log1pf(__expf(xa));
        float gv = -__expf(a_log[h]) * sp;
        gv = wave_scan_incl_f(gv);
        const float glast = __int_as_float(__builtin_amdgcn_readlane(__float_as_int(gv), 63));
        gc[lane] = gv; bet[lane] = bb; eg[lane] = __expf(gv); ek[lane] = __expf(glast - gv); rs[lane] = bb; rs[64 + lane] = bb * __expf(gv);
        if (lane == 63) ((float*)(regA + A_GTOT))[cid] = __expf(gv);
    }
    gbar_sync(gb, lane);
    const int m = lane & 15, g = lane >> 4, mt = hw;
    f32x4 cqk[4];
    {
        bf16x8 ak[4], aq[4];
#pragma unroll
        for (int ks = 0; ks < 4; ++ks) { ak[ks] = *(const LAS bf16x8*)(kn + (16 * mt + m) * 136 + 32 * ks + 8 * g); aq[ks] = *(const LAS bf16x8*)(qn + (16 * mt + m) * 136 + 32 * ks + 8 * g); }
#pragma unroll
        for (int nt = 0; nt < 4; ++nt) {
            f32x4 ckk = (f32x4){0.f, 0.f, 0.f, 0.f}; cqk[nt] = (f32x4){0.f, 0.f, 0.f, 0.f};
            if (nt <= mt) {
#pragma unroll
                for (int ks = 0; ks < 4; ++ks) { const bf16x8 bk = *(const LAS bf16x8*)(kn + (16 * nt + m) * 136 + 32 * ks + 8 * g);
                    ckk = __builtin_amdgcn_mfma_f32_16x16x32_bf16(ak[ks], bk, ckk, 0, 0, 0);
                    cqk[nt] = __builtin_amdgcn_mfma_f32_16x16x32_bf16(aq[ks], bk, cqk[nt], 0, 0, 0); }
            }
            const int j = 16 * nt + m; const float gj = gc[j];
#pragma unroll
            for (int jj = 0; jj < 4; ++jj) { const int i = 16 * mt + 4 * g + jj; const float dec = __expf(gc[i] - gj);
                As[i * 64 + j] = (i > j) ? bet[i] * ckk[jj] * dec : 0.f;
                cqk[nt][jj] = (i >= j) ? cqk[nt][jj] * dec : 0.f; }
        }
    }
    gbar_sync(gb, lane);
    float xs[64];
    {
        const int col = (hw & 1) * 64 + lane;
        const LAS bf16_t* rp = (hw < 2 ? vb : kn) + col;
        const LAS float* sp = rs + (hw < 2 ? 0 : 64);
#pragma unroll
        for (int rb = 0; rb < 4; ++rb) {
            float acc[16];
#pragma unroll
            for (int ii = 0; ii < 16; ++ii) acc[ii] = bf2f(rp[(16 * rb + ii) * 136]) * sp[16 * rb + ii];
#pragma unroll
            for (int hf = 0; hf < 2; ++hf)
#pragma unroll
            for (int j4 = 0; j4 < 4 * rb; ++j4) {
                asm volatile("" ::: "memory");
                f32x4 av[8];
#pragma unroll
                for (int ii = 0; ii < 8; ++ii) av[ii] = *(const LAS f32x4*)(As + (16 * rb + 8 * hf + ii) * 64 + 4 * j4);
#pragma unroll
                for (int ii = 0; ii < 8; ++ii) acc[8 * hf + ii] -= av[ii][0] * xs[4 * j4] + av[ii][1] * xs[4 * j4 + 1] + av[ii][2] * xs[4 * j4 + 2] + av[ii][3] * xs[4 * j4 + 3];
            }
#pragma unroll
            for (int i4 = 0; i4 < 4; ++i4) {
                asm volatile("" ::: "memory");
                f32x4 dv[4][4];
#pragma unroll
                for (int q = 0; q < 4; ++q)
#pragma unroll
                    for (int j4 = 0; j4 <= i4; ++j4) dv[q][j4] = *(const LAS f32x4*)(As + (16 * rb + 4 * i4 + q) * 64 + 16 * rb + 4 * j4);
#pragma unroll
                for (int q = 0; q < 4; ++q) { const int ii = 4 * i4 + q; float s = acc[ii];
#pragma unroll
                    for (int jj = 0; jj < ii; ++jj) s -= dv[q][jj >> 2][jj & 3] * xs[16 * rb + jj];
                    asm volatile("" : "+v"(s));
                    xs[16 * rb + ii] = s; }
            }
        }
    }
    gbar_sync(gb, lane);
    LAS bf16_t* wsl = (LAS bf16_t*)(lds + DH_VB); LAS bf16_t* QKs = (LAS bf16_t*)(lds + DH_AS);
    if (hw < 2) {
        bf16_t* ut = (bf16_t*)(regA + A_UT) + ((size_t)cid * 128 + hw * 64 + lane) * 64;
#pragma unroll
        for (int i = 0; i < 64; i += 8) { u32x4 o; o.x = cvt_pk_bf16(xs[i], xs[i + 1]); o.y = cvt_pk_bf16(xs[i + 2], xs[i + 3]); o.z = cvt_pk_bf16(xs[i + 4], xs[i + 5]); o.w = cvt_pk_bf16(xs[i + 6], xs[i + 7]);
            *(u32x4*)(ut + i) = o; }
    } else {
        const int col = (hw & 1) * 64 + lane;
#pragma unroll
        for (int i = 0; i < 64; ++i) wsl[i * 136 + col] = f2bf(xs[i]);
    }
#pragma unroll
    for (int nt = 0; nt < 4; ++nt) { const int j = 16 * nt + m;
#pragma unroll
        for (int jj = 0; jj < 4; ++jj) QKs[(16 * mt + 4 * g + jj) * 72 + j] = f2bf(cqk[nt][jj]); }
    gbar_sync(gb, lane);
    {
        bf16_t* rec = (bf16_t*)(regC + (size_t)cid * DN_REC_BYTES);
        dn_write_frags([&](int r, int c) { return bf2f(wsl[r * 136 + c]); }, 16, 4, rec, ht);
        dn_write_frags([&](int r, int c) { return bf2f(qn[r * 136 + c]) * eg[r]; }, 16, 4, rec + 16 * 512, ht);
        dn_write_frags([&](int r, int c) { return bf2f(QKs[r * 72 + c]); }, 8, 2, rec + 32 * 512, ht);
        dn_write_frags([&](int r, int c) { return bf2f(kn[c * 136 + r]) * ek[c]; }, 16, 2, rec + 40 * 512, ht);
    }
    gbar_sync(gb, lane);
}

__device__ __forceinline__ void p4_dn_scan(LAS unsigned char* lds, unsigned char* __restrict__ regA, const unsigned char* __restrict__ regC, int bh, int tid) {
    const int lane = tid & 63, wave = __builtin_amdgcn_readfirstlane(tid >> 6), m = lane & 15, g = lane >> 4;
    LAS unsigned char* buf = lds;
    static_assert(2 * DN_REC_BYTES <= LDS_MAIN_BYTES, "scan LDS");
    f32x4 S[8];
#pragma unroll
    for (int i = 0; i < 8; ++i) S[i] = (f32x4){0.f, 0.f, 0.f, 0.f};
    const unsigned char* rec0 = regC + (size_t)bh * 128 * DN_REC_BYTES;
    bf16_t* ut0 = (bf16_t*)(regA + A_UT) + (size_t)bh * 128 * 128 * 64 + (size_t)(16 * wave + m) * 64 + 4 * g;
    const float* gtot = (const float*)(regA + A_GTOT) + bh * 128;
    const float gt_lo = gtot[lane], gt_hi = gtot[64 + lane];
#pragma unroll
    for (int i = 0; i < 7; ++i) { const int piece = wave * 7 + i;
        __builtin_amdgcn_global_load_lds((const unsigned*)(rec0 + (size_t)piece * 1024 + lane * 16), (LAS unsigned*)(buf + piece * 1024), 16, 0, 0); }
    u32x2 un[4];
#define SCAN_FETCH(n_) do { _Pragma("unroll") for (int mt = 0; mt < 4; ++mt) un[mt] = *(const u32x2*)(ut0 + (size_t)(n_) * 128 * 64 + 16 * mt); } while (0)
#define SCAN_LANDED(cnt) asm volatile("s_waitcnt vmcnt(" #cnt ")" : "+v"(un[0]), "+v"(un[1]), "+v"(un[2]), "+v"(un[3]) :: "memory")
    SCAN_FETCH(0);
    SCAN_LANDED(0);
    for (int n = 0; n < NCH; ++n) {
        __syncthreads();
        f32x4 u[4];
#pragma unroll
        for (int mt = 0; mt < 4; ++mt) u[mt] = (f32x4){bflo(un[mt].x), bfhi(un[mt].x), bflo(un[mt].y), bfhi(un[mt].y)};
        if (n + 1 < NCH) {
            const unsigned char* rn = rec0 + (size_t)(n + 1) * DN_REC_BYTES; LAS unsigned char* bn = buf + ((n + 1) & 1) * DN_REC_BYTES;
#pragma unroll
            for (int i = 0; i < 7; ++i) { const int piece = wave * 7 + i;
                __builtin_amdgcn_global_load_lds((const unsigned*)(rn + (size_t)piece * 1024 + lane * 16), (LAS unsigned*)(bn + piece * 1024), 16, 0, 0); }
            SCAN_FETCH(n + 1);
        }
        const LAS unsigned char* bc = buf + (n & 1) * DN_REC_BYTES;
        const float gt = __builtin_bit_cast(float, __builtin_amdgcn_readlane(__builtin_bit_cast(int, n < 64 ? gt_lo : gt_hi), n & 63));
        bf16x8 Sb[4];
#pragma unroll
        for (int ks = 0; ks < 4; ++ks) { u32x4 w; w.x = cvt_pk_bf16(S[2 * ks][0], S[2 * ks][1]); w.y = cvt_pk_bf16(S[2 * ks][2], S[2 * ks][3]); w.z = cvt_pk_bf16(S[2 * ks + 1][0], S[2 * ks + 1][1]); w.w = cvt_pk_bf16(S[2 * ks + 1][2], S[2 * ks + 1][3]);
            Sb[ks] = __builtin_bit_cast(bf16x8, w); }
        f32x4 vn[4];
#pragma unroll
        for (int mt = 0; mt < 4; ++mt) { f32x4 acc = (f32x4){0.f, 0.f, 0.f, 0.f};
#pragma unroll
            for (int ks = 0; ks < 4; ++ks) { const bf16x8 af = *(const LAS bf16x8*)(bc + (mt * 4 + ks) * 1024 + lane * 16); acc = __builtin_amdgcn_mfma_f32_16x16x32_bf16(af, Sb[ks], acc, 0, 0, 0); }
            vn[mt] = u[mt] - acc; }
        bf16x8 Vb[2];
#pragma unroll
        for (int ks = 0; ks < 2; ++ks) { u32x4 w; w.x = cvt_pk_bf16(vn[2 * ks][0], vn[2 * ks][1]); w.y = cvt_pk_bf16(vn[2 * ks][2], vn[2 * ks][3]); w.z = cvt_pk_bf16(vn[2 * ks + 1][0], vn[2 * ks + 1][1]); w.w = cvt_pk_bf16(vn[2 * ks + 1][2], vn[2 * ks + 1][3]);
            Vb[ks] = __builtin_bit_cast(bf16x8, w); }
#pragma unroll
        for (int mt = 0; mt < 4; ++mt) { f32x4 acc = (f32x4){0.f, 0.f, 0.f, 0.f};
#pragma unroll
            for (int ks = 0; ks < 4; ++ks) { const bf16x8 af = *(const LAS bf16x8*)(bc + (16 + mt * 4 + ks) * 1024 + lane * 16); acc = __builtin_amdgcn_mfma_f32_16x16x32_bf16(af, Sb[ks], acc, 0, 0, 0); }
#pragma unroll
            for (int ks = 0; ks < 2; ++ks) { const bf16x8 af = *(const LAS bf16x8*)(bc + (32 + mt * 2 + ks) * 1024 + lane * 16); acc = __builtin_amdgcn_mfma_f32_16x16x32_bf16(af, Vb[ks], acc, 0, 0, 0); }
            const float o0 = acc[0], o1 = acc[1], o2 = acc[2], o3 = acc[3];
            u32x2 ow; ow.x = cvt_pk_bf16_mfma(o0, o1); ow.y = cvt_pk_bf16(o2, o3);
            *(u32x2*)(ut0 + (size_t)n * 128 * 64 + 16 * mt) = ow; }
#pragma unroll
        for (int mt = 0; mt < 8; ++mt) { f32x4 acc = S[mt] * gt;
#pragma unroll
            for (int ks = 0; ks < 2; ++ks) { const bf16x8 af = *(const LAS bf16x8*)(bc + (40 + mt * 2 + ks) * 1024 + lane * 16); acc = __builtin_amdgcn_mfma_f32_16x16x32_bf16(af, Vb[ks], acc, 0, 0, 0); }
            S[mt] = acc; }
        SCAN_LANDED(4);
    }
#undef SCAN_FETCH
#undef SCAN_LANDED
    asm volatile("s_waitcnt vmcnt(0)" ::: "memory");
    __syncthreads();
}

__device__ __forceinline__ void p5_dn_finish(LAS unsigned char* lds, bf16_t* __restrict__ P, const float* __restrict__ dn_g, const unsigned char* __restrict__ regA, int blk, int nblk, int tid) {
    LAS float* ot = (LAS float*)lds;
    const int dvr = tid >> 2, p0 = (tid & 3) * 16;
    const int pos = tid >> 3, d0 = (tid & 7) * 16;
    float gl[16];
#pragma unroll
    for (int j = 0; j < 16; ++j) gl[j] = dn_g[d0 + j];
    u32x4 ra = (u32x4){0u, 0u, 0u, 0u}, rc = ra;
    if (blk < 2048) { const bf16_t* src = (const bf16_t*)(regA + A_UT) + (size_t)blk * 128 * 64; ra = *(const u32x4*)(src + dvr * 64 + p0); rc = *(const u32x4*)(src + dvr * 64 + p0 + 8); }
    for (int cid = blk; cid < 2048; cid += nblk) {
        const int n = cid & 127, bh = cid >> 7, b = bh >> 2, h = bh & 3, tok0 = b * SEQ + n * CHUNK;
        bf16_t* row = P + (size_t)(tok0 + pos) * NP;
        const u32x4 z0 = *(const u32x4*)(row + PC_Z + h * 128 + d0), z1 = *(const u32x4*)(row + PC_Z + h * 128 + d0 + 8);
        __syncthreads();
        { LAS float* o = ot + dvr * 65 + p0;
          o[0] = bflo(ra.x); o[1] = bfhi(ra.x); o[2] = bflo(ra.y); o[3] = bfhi(ra.y); o[4] = bflo(ra.z); o[5] = bfhi(ra.z); o[6] = bflo(ra.w); o[7] = bfhi(ra.w);
          o[8] = bflo(rc.x); o[9] = bfhi(rc.x); o[10] = bflo(rc.y); o[11] = bfhi(rc.y); o[12] = bflo(rc.z); o[13] = bfhi(rc.z); o[14] = bflo(rc.w); o[15] = bfhi(rc.w); }
        if (cid + nblk < 2048) { const bf16_t* src = (const bf16_t*)(regA + A_UT) + (size_t)(cid + nblk) * 128 * 64; ra = *(const u32x4*)(src + dvr * 64 + p0); rc = *(const u32x4*)(src + dvr * 64 + p0 + 8); }
        __syncthreads();
        float v[16]; float ss = 0.f;
#pragma unroll
        for (int j = 0; j < 16; ++j) { v[j] = ot[(d0 + j) * 65 + pos]; ss += v[j] * v[j]; }
        ss = oct_sum(ss);
        const float rstd = rsqrtf(ss * (1.0f / 128.0f) + EPS);
        const float zf[16] = {bflo(z0.x), bfhi(z0.x), bflo(z0.y), bfhi(z0.y), bflo(z0.z), bfhi(z0.z), bflo(z0.w), bfhi(z0.w), bflo(z1.x), bfhi(z1.x), bflo(z1.y), bfhi(z1.y), bflo(z1.z), bfhi(z1.z), bflo(z1.w), bfhi(z1.w)};
        float r[16];
#pragma unroll
        for (int j = 0; j < 16; ++j) r[j] = v[j] * rstd * gl[j] * silu_f(zf[j]);
        u32x4 w0, w1;
        w0.x = cvt_pk_bf16(r[0], r[1]); w0.y = cvt_pk_bf16(r[2], r[3]); w0.z = cvt_pk_bf16(r[4], r[5]); w0.w = cvt_pk_bf16(r[6], r[7]);
        w1.x = cvt_pk_bf16(r[8], r[9]); w1.y = cvt_pk_bf16(r[10], r[11]); w1.z = cvt_pk_bf16(r[12], r[13]); w1.w = cvt_pk_bf16(r[14], r[15]);
        *(u32x4*)(row + h * 128 + d0) = w0; *(u32x4*)(row + h * 128 + d0 + 8) = w1;
    }
    __syncthreads();
}

constexpr int AT_SC = 0;
constexpr int AT_RS = 8192 * 2 + 32;
constexpr int AT_HIST = 4 * AT_RS;
constexpr int AT_GRP = AT_HIST + 4 * 1024;
constexpr int AT_KV = 0;
constexpr int AT_KV_WAVE = 32 * 544;
static_assert(2 * AT_GRP <= LDS_MAIN_BYTES && 4 * AT_KV_WAVE <= AT_GRP, "attention LDS");
constexpr float SM_SCALE = 0.08838834764831845f;

__device__ __forceinline__ unsigned score_key(float s) { const unsigned u = __float_as_uint(s); return (u ^ ((unsigned)((int)u >> 31) | 0x80000000u)) >> 16; }
__device__ __forceinline__ float relu_f(float x) { return __builtin_amdgcn_fmed3f(x, 0.f, 3.0e38f); }

__device__ __forceinline__ unsigned suffix_above(unsigned lane_sum, int lane) {
    const unsigned inc = wave_scan_incl(lane_sum);
    return (unsigned)__builtin_amdgcn_readlane((int)inc, 63) - inc;
}
__device__ __forceinline__ void find_bin(const LAS unsigned* hist, int lane, unsigned need, unsigned& bin, unsigned& above) {
    const u32x4 c = *(const LAS u32x4*)(hist + 4 * lane);
    const unsigned ls = c.x + c.y + c.z + c.w;
    const unsigned ab3 = suffix_above(ls, lane);
    const unsigned ab2 = ab3 + c.w, ab1 = ab2 + c.z, ab0 = ab1 + c.y;
    unsigned mybin = 0xffffffffu, myab = 0;
    if (ab3 < need && need <= ab3 + c.w) { mybin = 4 * lane + 3; myab = ab3; }
    else if (ab2 < need && need <= ab2 + c.z) { mybin = 4 * lane + 2; myab = ab2; }
    else if (ab1 < need && need <= ab1 + c.y) { mybin = 4 * lane + 1; myab = ab1; }
    else if (ab0 < need && need <= ab0 + c.x) { mybin = 4 * lane + 0; myab = ab0; }
    const unsigned long long bal = __ballot(mybin != 0xffffffffu);
    const int src = bal ? (int)__builtin_ctzll(bal) : 0;
    bin = (unsigned)__builtin_amdgcn_readlane((int)mybin, src); above = (unsigned)__builtin_amdgcn_readlane((int)myab, src);
}

#define TR8(o0, o1, o2, o3, o4, o5, o6, o7, alo, ahi, F0, F1, F2, F3) \
    asm volatile("ds_read_b64_tr_b16 %0, %8 offset:" #F0 "\n\tds_read_b64_tr_b16 %1, %9 offset:" #F0 "\n\t" \
                 "ds_read_b64_tr_b16 %2, %8 offset:" #F1 "\n\tds_read_b64_tr_b16 %3, %9 offset:" #F1 "\n\t" \
                 "ds_read_b64_tr_b16 %4, %8 offset:" #F2 "\n\tds_read_b64_tr_b16 %5, %9 offset:" #F2 "\n\t" \
                 "ds_read_b64_tr_b16 %6, %8 offset:" #F3 "\n\tds_read_b64_tr_b16 %7, %9 offset:" #F3 "\n\ts_waitcnt lgkmcnt(0)" \
                 : "=&v"(o0), "=&v"(o1), "=&v"(o2), "=&v"(o3), "=&v"(o4), "=&v"(o5), "=&v"(o6), "=&v"(o7) : "v"(alo), "v"(ahi) : "memory")

__device__ __forceinline__ void p4_attn_item(LAS unsigned char* lds, LAS unsigned short* idxl  , bf16_t* __restrict__ P, const bf16_t* __restrict__ CKV, const bf16_t* __restrict__ KIX, const float* __restrict__ WIX,
                                             int b, int item, int tid, GBar& gb) {
    const int lane = tid & 63, wave = __builtin_amdgcn_readfirstlane(tid >> 6), w4 = wave & 3, m = lane & 15, g = lane >> 4;
    const int c = 127 - (item >> 4), sub = item & 15;
    const int limit = 64 * (c + 1), q0 = b * SEQ + c * 64 + sub * 4;
    const int nsel = limit < 256 ? limit : 256;
    LAS unsigned* qmaxl = (LAS unsigned*)(idxl + 8 * 256) + (wave >> 2) * 16;
    LAS unsigned short* myidx = idxl + wave * 256;
    if (limit > 256) {
        bf16x8 aq[2]; f32x4 wq;
        { const int q = m >> 2, hh = m & 3;
#pragma unroll
          for (int ks = 0; ks < 2; ++ks) aq[ks] = *(const bf16x8*)(P + (size_t)(q0 + q) * NP + PC_QIX + hh * 64 + 32 * ks + 8 * g);
          wq = *(const f32x4*)(WIX + (size_t)(q0 + g) * 4); }
        const bf16_t* kb = KIX + (size_t)b * SEQ * 64;
        const int ntile = limit / 16, ni = (ntile - w4 + 3) >> 2, ng = (ni + 3) >> 2;
        bf16x8 kA0[4], kA1[4], kB0[4], kB1[4]; unsigned mk = 0u;
#define SC_TILE(r0, r1, u, kt) do { \
                f32x4 acc = (f32x4){0.f, 0.f, 0.f, 0.f}; \
                acc = __builtin_amdgcn_mfma_f32_16x16x32_bf16(aq[0], r0[u], acc, 0, 0, 0); \
                acc = __builtin_amdgcn_mfma_f32_16x16x32_bf16(aq[1], r1[u], acc, 0, 0, 0); \
                const float sv = wq[0] * relu_f(acc[0]) + wq[1] * relu_f(acc[1]) + wq[2] * relu_f(acc[2]) + wq[3] * relu_f(acc[3]); \
                const unsigned key = score_key(sv); mk = key > mk ? key : mk; \
                *(LAS unsigned short*)(lds + AT_SC + g * AT_RS + (16 * (kt) + m) * 2) = (unsigned short)key; } while (0)
#define SC_LOAD(r0, r1, gi_) do { _Pragma("unroll") for (int u = 0; u < 4; ++u) { const int i_ = (gi_) * 4 + u; if (i_ < ni) { const bf16_t* kp = kb + (size_t)(w4 + 4 * i_) * 1024 + lane * 8; r0[u] = *(const bf16x8*)kp; r1[u] = *(const bf16x8*)(kp + 512); } } } while (0)
#define SC_COMP(r0, r1, gi_) do { _Pragma("unroll") for (int u = 0; u < 4; ++u) { const int i_ = (gi_) * 4 + u; if (i_ < ni) { SC_TILE(r0, r1, u, w4 + 4 * i_); } } } while (0)
#define SC_LOAD_F(r0, r1, gi_) do { _Pragma("unroll") for (int u = 0; u < 4; ++u) { const bf16_t* kp = kb + (size_t)(w4 + 4 * ((gi_) * 4 + u)) * 1024 + lane * 8; r0[u] = *(const bf16x8*)kp; r1[u] = *(const bf16x8*)(kp + 512); } } while (0)
#define SC_COMP_F(r0, r1, gi_) do { _Pragma("unroll") for (int u = 0; u < 4; ++u) { SC_TILE(r0, r1, u, w4 + 4 * ((gi_) * 4 + u)); } } while (0)
        const int ngf = ni >> 2;
        if (ngf > 0) SC_LOAD_F(kA0, kA1, 0);
        int gi = 0;
        for (; gi + 1 < ngf; gi += 2) {
            SC_LOAD_F(kB0, kB1, gi + 1);
            SC_COMP_F(kA0, kA1, gi);
            if (gi + 2 < ngf) SC_LOAD_F(kA0, kA1, gi + 2);
            SC_COMP_F(kB0, kB1, gi + 1);
        }
        if (gi < ngf) { SC_COMP_F(kA0, kA1, gi); ++gi; }
        if (gi < ng) { SC_LOAD(kB0, kB1, gi); SC_COMP(kB0, kB1, gi); }
#undef SC_LOAD
#undef SC_COMP
#undef SC_LOAD_F
#undef SC_COMP_F
#undef SC_TILE
        { const unsigned v = row16_max_u(mk); if (m == 0) qmaxl[w4 * 4 + g] = v; }
        gbar_sync(gb, lane);
        {
            LAS unsigned* hist = (LAS unsigned*)(lds + AT_HIST) + w4 * 256;
            const LAS unsigned char* ms = lds + AT_SC + w4 * AT_RS;
            unsigned kmax = 0;
#pragma unroll
            for (int w = 0; w < 4; ++w) { const unsigned t = qmaxl[w * 4 + w4]; kmax = t > kmax ? t : kmax; }
#define KEY_E(v, e) (((e) & 1) ? ((v)[(e) >> 1] >> 16) : ((v)[(e) >> 1] & 0xffffu))
            unsigned T = 0, cnt_gt = 0;
            for (unsigned base = kmax, above = 0;;) {
                *(LAS u32x4*)(hist + 4 * lane) = (u32x4){0u, 0u, 0u, 0u};
                for (int i0 = 0; i0 < limit; i0 += 512) {
                    const u32x4 v = *(const LAS u32x4*)(ms + (i0 + lane * 8) * 2); const bool lv = i0 + lane * 8 < limit;
#pragma unroll
                    for (int e = 0; e < 8; ++e) { const unsigned d = base - KEY_E(v, e); if (lv && d < 255u) __hip_atomic_fetch_add(hist + d, 1u, __ATOMIC_RELAXED, __HIP_MEMORY_SCOPE_WORKGROUP); }
                }
                const unsigned need = 256u - above;
                const u32x4 c = *(const LAS u32x4*)(hist + 4 * lane);
                const unsigned ls = c.x + c.y + c.z + c.w, inc = wave_scan_incl(ls);
                const unsigned tot = (unsigned)__builtin_amdgcn_readlane((int)inc, 63), p0 = inc - ls, p1 = p0 + c.x, p2 = p1 + c.y, p3 = p2 + c.z;
                if (tot >= need) {
                    unsigned mybin = 0xffffffffu, myab = 0;
                    if (p0 < need && need <= p1) { mybin = 4 * lane; myab = p0; }
                    else if (p1 < need && need <= p2) { mybin = 4 * lane + 1; myab = p1; }
                    else if (p2 < need && need <= p3) { mybin = 4 * lane + 2; myab = p2; }
                    else if (p3 < need && need <= inc) { mybin = 4 * lane + 3; myab = p3; }
                    const unsigned long long bal = __ballot(mybin != 0xffffffffu); const int src = (int)__builtin_ctzll(bal);
                    T = base - (unsigned)__builtin_amdgcn_readlane((int)mybin, src); cnt_gt = above + (unsigned)__builtin_amdgcn_readlane((int)myab, src);
                    break;
                }
                above += tot;
                if (base < 255u || base + 255u < kmax) {
                    *(LAS u32x4*)(hist + 4 * lane) = (u32x4){0u, 0u, 0u, 0u};
                    for (int i0 = 0; i0 < limit; i0 += 512) {
                        const u32x4 v = *(const LAS u32x4*)(ms + (i0 + lane * 8) * 2); const bool lv = i0 + lane * 8 < limit;
#pragma unroll
                        for (int e = 0; e < 8; ++e) if (lv) __hip_atomic_fetch_add(hist + (KEY_E(v, e) >> 8), 1u, __ATOMIC_RELAXED, __HIP_MEMORY_SCOPE_WORKGROUP);
                    }
                    unsigned b1, above1; find_bin(hist, lane, 256u, b1, above1);
                    *(LAS u32x4*)(hist + 4 * lane) = (u32x4){0u, 0u, 0u, 0u};
                    for (int i0 = 0; i0 < limit; i0 += 512) {
                        const u32x4 v = *(const LAS u32x4*)(ms + (i0 + lane * 8) * 2); const bool lv = i0 + lane * 8 < limit;
#pragma unroll
                        for (int e = 0; e < 8; ++e) { const unsigned k = KEY_E(v, e); if (lv && (k >> 8) == b1) __hip_atomic_fetch_add(hist + (k & 255u), 1u, __ATOMIC_RELAXED, __HIP_MEMORY_SCOPE_WORKGROUP); }
                    }
                    unsigned b2, above2; find_bin(hist, lane, 256u - above1, b2, above2);
                    T = (b1 << 8) | b2; cnt_gt = above1 + above2;
                    break;
                }
                base -= 255u;
            }
            const unsigned need_eq = 256u - cnt_gt;
            unsigned cur_gt = 0, cur_eq = 0;
            LAS unsigned short* dummy = (LAS unsigned short*)hist + lane;
            for (int i0 = 0; i0 < limit; i0 += 512) {
                const u32x4 v = *(const LAS u32x4*)(ms + (i0 + lane * 8) * 2); const bool lv = i0 + lane * 8 < limit;
                unsigned eqm = 0;
#pragma unroll
                for (int e = 0; e < 8; ++e) {
                    const unsigned k = KEY_E(v, e);
                    const bool gt = lv && k > T;
                    eqm |= (lv && k == T) ? (1u << e) : 0u;
                    const unsigned long long mg = __ballot(gt);
                    const unsigned slot = cur_gt + __builtin_amdgcn_mbcnt_hi((unsigned)(mg >> 32), __builtin_amdgcn_mbcnt_lo((unsigned)mg, 0u));
                    LAS unsigned short* dstp = gt ? myidx + slot : dummy;
                    *dstp = (unsigned short)(i0 + lane * 8 + e);
                    cur_gt += __builtin_popcountll(mg);
                }
                if (__ballot(eqm != 0u) != 0ull && cur_eq < need_eq) {
                    const unsigned ce = __builtin_popcount(eqm); const unsigned inc = wave_scan_incl(ce);
                    unsigned r = cur_eq + inc - ce;
#pragma unroll
                    for (int e = 0; e < 8; ++e) if (eqm & (1u << e)) { if (r < need_eq) myidx[cnt_gt + r] = (unsigned short)(i0 + lane * 8 + e); ++r; }
                    cur_eq += (unsigned)__builtin_amdgcn_readlane((int)inc, 63);
                }
            }
#undef KEY_E
        }
    } else {
        for (int i = lane; i < nsel; i += 64) myidx[i] = (unsigned short)i;
    }
    gbar_sync(gb, lane);
    {
        const int tq = q0 + w4;
        bf16x8 qf[8];
#pragma unroll
        for (int ks = 0; ks < 8; ++ks) { u32x4 z = (u32x4){0u, 0u, 0u, 0u};
            if (m < 4) z = *(const u32x4*)(P + (size_t)tq * NP + PC_QLAT + m * 256 + 32 * ks + 8 * g);
            qf[ks] = __builtin_bit_cast(bf16x8, z); }
        LAS unsigned char* kvs = lds + AT_KV + w4 * AT_KV_WAVE;
        const unsigned tr_lo = (unsigned)(size_t)kvs + (unsigned)((4 * g + (m >> 2)) * 544 + (m & 3) * 8);
        const unsigned tr_hi = tr_lo + 16 * 544;
        f32x4 O[16];
#pragma unroll
        for (int i = 0; i < 16; ++i) O[i] = (f32x4){0.f, 0.f, 0.f, 0.f};
        float mrun = -1e30f, lrun = 0.f;
        const bf16_t* cb = CKV + (size_t)b * SEQ * 256;
        bf16x8 kr[16];
        const int rsel = lane >> 5, rpc = (lane & 31) * 8;
#define AT_LOADK(st_) do { _Pragma("unroll") for (int i_ = 0; i_ < 16; ++i_) { const int kidx = myidx[32 * (st_) + 2 * i_ + rsel]; kr[i_] = *(const bf16x8*)(cb + (size_t)kidx * 256 + rpc); } } while (0)
        AT_LOADK(0);
        const int nst = nsel / 32;
        for (int st = 0; st < nst; ++st) {
#pragma unroll
            for (int i_ = 0; i_ < 16; ++i_) *(LAS bf16x8*)(kvs + (2 * i_ + rsel) * 544 + rpc * 2) = kr[i_];
            asm volatile("s_waitcnt lgkmcnt(0)" ::: "memory");
            if (st + 1 < nst) AT_LOADK(st + 1);
            f32x4 s[2];
#pragma unroll
            for (int mt = 0; mt < 2; ++mt) { s[mt] = (f32x4){0.f, 0.f, 0.f, 0.f};
#pragma unroll
                for (int ks = 0; ks < 8; ++ks) { const bf16x8 kfr = *(const LAS bf16x8*)(kvs + (16 * mt + m) * 544 + (32 * ks + 8 * g) * 2); s[mt] = __builtin_amdgcn_mfma_f32_16x16x32_bf16(kfr, qf[ks], s[mt], 0, 0, 0); } }
            float mx = -1e30f;
#pragma unroll
            for (int mt = 0; mt < 2; ++mt)
#pragma unroll
                for (int jj = 0; jj < 4; ++jj) { s[mt][jj] *= SM_SCALE; mx = fmaxf(mx, s[mt][jj]); }
            mx = xrow_max(mx);
            const float mnew = fmaxf(mrun, mx), alpha = __expf(mrun - mnew);
            float ps = 0.f; float p[2][4];
#pragma unroll
            for (int mt = 0; mt < 2; ++mt)
#pragma unroll
                for (int jj = 0; jj < 4; ++jj) { p[mt][jj] = __expf(s[mt][jj] - mnew); ps += p[mt][jj]; }
            lrun = lrun * alpha + ps; mrun = mnew;
            u32x4 pw; pw.x = cvt_pk_bf16(p[0][0], p[0][1]); pw.y = cvt_pk_bf16(p[0][2], p[0][3]); pw.z = cvt_pk_bf16(p[1][0], p[1][1]); pw.w = cvt_pk_bf16(p[1][2], p[1][3]);
            const bf16x8 pb = __builtin_bit_cast(bf16x8, pw);
#pragma unroll
            for (int i = 0; i < 16; ++i) O[i] *= alpha;
            asm volatile("s_waitcnt lgkmcnt(0)" ::: "memory");
#define AT_PV2(dt0, F0, F1, F2, F3, F4, F5, F6, F7) do { bf16x4 l0, h0, l1, h1, l2, h2, l3, h3, l4, h4, l5, h5, l6, h6, l7, h7; \
            asm volatile("ds_read_b64_tr_b16 %0, %16 offset:" #F0 "\n\tds_read_b64_tr_b16 %1, %17 offset:" #F0 "\n\tds_read_b64_tr_b16 %2, %16 offset:" #F1 "\n\tds_read_b64_tr_b16 %3, %17 offset:" #F1 "\n\t" \
                         "ds_read_b64_tr_b16 %4, %16 offset:" #F2 "\n\tds_read_b64_tr_b16 %5, %17 offset:" #F2 "\n\tds_read_b64_tr_b16 %6, %16 offset:" #F3 "\n\tds_read_b64_tr_b16 %7, %17 offset:" #F3 "\n\t" \
                         "ds_read_b64_tr_b16 %8, %16 offset:" #F4 "\n\tds_read_b64_tr_b16 %9, %17 offset:" #F4 "\n\tds_read_b64_tr_b16 %10, %16 offset:" #F5 "\n\tds_read_b64_tr_b16 %11, %17 offset:" #F5 "\n\t" \
                         "ds_read_b64_tr_b16 %12, %16 offset:" #F6 "\n\tds_read_b64_tr_b16 %13, %17 offset:" #F6 "\n\tds_read_b64_tr_b16 %14, %16 offset:" #F7 "\n\tds_read_b64_tr_b16 %15, %17 offset:" #F7 "\n\ts_waitcnt lgkmcnt(8)" \
                         : "=&v"(l0), "=&v"(h0), "=&v"(l1), "=&v"(h1), "=&v"(l2), "=&v"(h2), "=&v"(l3), "=&v"(h3), "=&v"(l4), "=&v"(h4), "=&v"(l5), "=&v"(h5), "=&v"(l6), "=&v"(h6), "=&v"(l7), "=&v"(h7) \
                         : "v"(tr_lo), "v"(tr_hi) : "memory"); \
            O[dt0 + 0] = __builtin_amdgcn_mfma_f32_16x16x32_bf16(__builtin_shufflevector(l0, h0, 0, 1, 2, 3, 4, 5, 6, 7), pb, O[dt0 + 0], 0, 0, 0); \
            O[dt0 + 1] = __builtin_amdgcn_mfma_f32_16x16x32_bf16(__builtin_shufflevector(l1, h1, 0, 1, 2, 3, 4, 5, 6, 7), pb, O[dt0 + 1], 0, 0, 0); \
            O[dt0 + 2] = __builtin_amdgcn_mfma_f32_16x16x32_bf16(__builtin_shufflevector(l2, h2, 0, 1, 2, 3, 4, 5, 6, 7), pb, O[dt0 + 2], 0, 0, 0); \
            O[dt0 + 3] = __builtin_amdgcn_mfma_f32_16x16x32_bf16(__builtin_shufflevector(l3, h3, 0, 1, 2, 3, 4, 5, 6, 7), pb, O[dt0 + 3], 0, 0, 0); \
            asm volatile("s_waitcnt lgkmcnt(0)" : "+v"(l4), "+v"(h4), "+v"(l5), "+v"(h5), "+v"(l6), "+v"(h6), "+v"(l7), "+v"(h7) :: "memory"); \
            O[dt0 + 4] = __builtin_amdgcn_mfma_f32_16x16x32_bf16(__builtin_shufflevector(l4, h4, 0, 1, 2, 3, 4, 5, 6, 7), pb, O[dt0 + 4], 0, 0, 0); \
            O[dt0 + 5] = __builtin_amdgcn_mfma_f32_16x16x32_bf16(__builtin_shufflevector(l5, h5, 0, 1, 2, 3, 4, 5, 6, 7), pb, O[dt0 + 5], 0, 0, 0); \
            O[dt0 + 6] = __builtin_amdgcn_mfma_f32_16x16x32_bf16(__builtin_shufflevector(l6, h6, 0, 1, 2, 3, 4, 5, 6, 7), pb, O[dt0 + 6], 0, 0, 0); \
            O[dt0 + 7] = __builtin_amdgcn_mfma_f32_16x16x32_bf16(__builtin_shufflevector(l7, h7, 0, 1, 2, 3, 4, 5, 6, 7), pb, O[dt0 + 7], 0, 0, 0); } while (0)
            AT_PV2(0, 0, 32, 64, 96, 128, 160, 192, 224); AT_PV2(8, 256, 288, 320, 352, 384, 416, 448, 480);
#undef AT_PV2
        }
#undef AT_LOADK
        const float inv = __builtin_amdgcn_rcpf(xrow_sum(lrun));
        if (m < 4) {
            bf16_t* op = P + (size_t)tq * NP + 512 + m * 256 + 4 * g;
#pragma unroll
            for (int dt = 0; dt < 16; ++dt) { u32x2 w; w.x = cvt_pk_bf16(O[dt][0] * inv, O[dt][1] * inv); w.y = cvt_pk_bf16(O[dt][2] * inv, O[dt][3] * inv); *(u32x2*)(op + 16 * dt) = w; }
        }
    }
    gbar_sync(gb, lane);
}

constexpr int P6_W = 8192, P6_WS = 272  , P6_WHALF = 64 * P6_WS, P6_H = P6_W + 2 * P6_WHALF, P6_HS = 272, P6_HHALF = 16 * P6_HS, P6_HW = 2 * P6_HHALF > 16 * 64 * 4 ? 2 * P6_HHALF : 16 * 64 * 4;
static_assert(P6_H + 8 * P6_HW <= LDS_MAIN_BYTES, "phase 6 LDS");
__device__ __forceinline__ void p6_norm_route(LAS unsigned char* lds, const float* __restrict__ X1, const float* __restrict__ gain, const float* __restrict__ modp, const float* __restrict__ ada_b,
                                              const float* __restrict__ rw, const float* __restrict__ rb, bf16_t* __restrict__ H2, unsigned char* __restrict__ tab, int blk, int nblk, int tid) {
    const int wave = __builtin_amdgcn_readfirstlane(tid >> 6), lane = tid & 63, m = lane & 15, g = lane >> 4;
    LAS float* sm = (LAS float*)lds;
    LAS unsigned char* Wl = lds + P6_W;
    LAS unsigned char* hwb = lds + P6_H + wave * P6_HW;
    LAS float* hw = (LAS float*)hwb;
    LAS int* cntw = (LAS int*)(lds + LDS_AUX);
    int* RTE = (int*)(tab + T_RTE); float* RTG = (float*)(tab + T_RTG); int* CNT = (int*)(tab + T_CNT);
    const float rbias = rb[lane];
    for (int tb = blk; tb < NTOK / 128; tb += nblk) {
        const int b = (tb * 128) / SEQ;
        const size_t row0 = (size_t)tb * 128 + wave * 16;
        __syncthreads();
        load_mod(sm, modp, ada_b, b, 3072, 2048, tid);
        float rstd[16];
#pragma unroll
        for (int r4 = 0; r4 < 16; r4 += 4) {
            f32x4 v[4][4];
#pragma unroll
            for (int rr = 0; rr < 4; ++rr)
#pragma unroll
                for (int i = 0; i < 4; ++i) v[rr][i] = *(const f32x4*)(X1 + (row0 + r4 + rr) * DM + i * 256 + lane * 4);
#pragma unroll
            for (int rr = 0; rr < 4; ++rr) { float ss = 0.f;
#pragma unroll
                for (int i = 0; i < 4; ++i) ss += v[rr][i][0] * v[rr][i][0] + v[rr][i][1] * v[rr][i][1] + v[rr][i][2] * v[rr][i][2] + v[rr][i][3] * v[rr][i][3];
                rstd[r4 + rr] = rsqrtf(wave_sum(ss) * (1.0f / DM) + EPS); }
        }
        f32x4 acc[4];
#pragma unroll
        for (int nt = 0; nt < 4; ++nt) acc[nt] = (f32x4){0.f, 0.f, 0.f, 0.f};
        for (int kc = 0; kc < 8; ++kc) {
            __syncthreads();
            { const int wr_ = tid >> 2, pc = (tid & 3) * 16; const float* src = rw + (size_t)(kc * 128 + wr_) * 64 + pc;
#pragma unroll
              for (int i = 0; i < 4; ++i) { const f32x4 wv = *(const f32x4*)(src + 4 * i);
#pragma unroll
                  for (int j = 0; j < 4; ++j) { const bf16_t hi = f2bf(wv[j]); const bf16_t lo = f2bf(wv[j] - bf2f(hi)); const int n = pc + 4 * i + j;
                      *(LAS bf16_t*)(Wl + n * P6_WS + wr_ * 2) = hi; *(LAS bf16_t*)(Wl + P6_WHALF + n * P6_WS + wr_ * 2) = lo; } } }
            const int c0 = kc * 128 + lane * 2;
            const f32x2 gv = *(const f32x2*)(gain + c0);
            const float sh0 = sm[c0], sh1 = sm[c0 + 1], sc0 = 1.0f + sm[1024 + c0], sc1 = 1.0f + sm[1024 + c0 + 1];
            f32x2 xv[16];
#pragma unroll
            for (int r = 0; r < 16; ++r) xv[r] = *(const f32x2*)(X1 + (row0 + r) * DM + c0);
#pragma unroll
            for (int r = 0; r < 16; ++r) { const float h0 = xv[r][0] * rstd[r] * gv[0] * sc0 + sh0, h1 = xv[r][1] * rstd[r] * gv[1] * sc1 + sh1;
                const unsigned hi = cvt_pk_bf16(h0, h1);
                const unsigned lo = cvt_pk_bf16(h0 - bflo(hi), h1 - bfhi(hi));
                *(LAS unsigned*)(hwb + r * P6_HS + lane * 4) = hi; *(LAS unsigned*)(hwb + P6_HHALF + r * P6_HS + lane * 4) = lo;
                *(unsigned*)(H2 + (row0 + r) * DM + c0) = hi; }
            __syncthreads();
#pragma unroll
            for (int ks = 0; ks < 4; ++ks) {
                const bf16x8 ahi = *(const LAS bf16x8*)(hwb + m * P6_HS + (32 * ks + 8 * g) * 2), alo = *(const LAS bf16x8*)(hwb + P6_HHALF + m * P6_HS + (32 * ks + 8 * g) * 2);
#pragma unroll
                for (int nt = 0; nt < 4; ++nt) {
                    const bf16x8 bhi = *(const LAS bf16x8*)(Wl + (16 * nt + m) * P6_WS + (32 * ks + 8 * g) * 2), blo = *(const LAS bf16x8*)(Wl + P6_WHALF + (16 * nt + m) * P6_WS + (32 * ks + 8 * g) * 2);
                    acc[nt] = __builtin_amdgcn_mfma_f32_16x16x32_bf16(ahi, bhi, acc[nt], 0, 0, 0);
                    acc[nt] = __builtin_amdgcn_mfma_f32_16x16x32_bf16(ahi, blo, acc[nt], 0, 0, 0);
                    acc[nt] = __builtin_amdgcn_mfma_f32_16x16x32_bf16(alo, bhi, acc[nt], 0, 0, 0);
                }
            }
        }
#pragma unroll
        for (int nt = 0; nt < 4; ++nt)
#pragma unroll
            for (int j = 0; j < 4; ++j) hw[(4 * g + j) * 64 + 16 * nt + m] = acc[nt][j];
        int mycnt = 0;
        for (int r = 0; r < 16; ++r) {
            const size_t row = row0 + r;
            const float lg = hw[r * 64 + lane];
            const float s = sigmoid_f(lg), ch = s + rbias;
            float m1 = oct_max(ch);
            const unsigned long long bm = __ballot(ch == m1);
            const unsigned gm = (unsigned)((bm >> (lane & 56)) & 0xffull);
            const int first = __builtin_ctz(gm);
            float m2 = oct_max(((lane & 7) == first) ? -INFINITY : ch);
            const float gs = m1 + m2;
            int grank = 0; const int myg = lane >> 3;
#pragma unroll
            for (int g2 = 0; g2 < 8; ++g2) { const float o = __builtin_bit_cast(float, __builtin_amdgcn_readlane(__builtin_bit_cast(int, gs), g2 * 8)); grank += (o > gs || (o == gs && g2 < myg)) ? 1 : 0; }
            const float mc = grank < 4 ? ch : -INFINITY;
            int erank = 0;
#pragma unroll
            for (int e2 = 0; e2 < 64; ++e2) { const float o = __builtin_bit_cast(float, __builtin_amdgcn_readlane(__builtin_bit_cast(int, mc), e2)); erank += (o > mc || (o == mc && e2 < lane)) ? 1 : 0; }
            const bool sel = erank < 8;
            float gsum = sel ? s : 0.f; gsum = wave_sum(gsum);
            const unsigned long long sb = __ballot(sel);
            const int slot = __builtin_popcountll(sb & ((1ull << lane) - 1ull));
            if (sel && slot < 8) { RTE[row * 8 + slot] = lane; RTG[row * 8 + slot] = s / gsum * 2.5f; mycnt += 1; }
        }
        cntw[wave * 64 + lane] = mycnt;
        __syncthreads();
        if (tid < 64) { int c = 0;
#pragma unroll
            for (int w = 0; w < 8; ++w) c += cntw[w * 64 + tid];
            CNT[tid * 256 + tb] = c; }
    }
    __syncthreads();
}

__device__ __forceinline__ void p7_place(LAS unsigned char* lds, unsigned char* __restrict__ tab, int blk, int nblk, int tid) {
    const int wave = tid >> 6, lane = tid & 63;
    const int* RTE = (const int*)(tab + T_RTE); const float* RTG = (const float*)(tab + T_RTG); const int* CNT = (const int*)(tab + T_CNT);
    int* STOK = (int*)(tab + T_STOK); float* SGATE = (float*)(tab + T_SGATE); int* OFFS = (int*)(tab + T_OFFS); int* TILE = (int*)(tab + T_TILE); int* META = (int*)(tab + T_META); int* POS = (int*)(tab + T_POS);
    LAS int* tot = (LAS int*)lds; LAS int* pre = tot + 64; LAS int* base = tot + 128; LAS int* le = tot + 256; LAS float* lg = (LAS float*)(tot + 256 + 1024); LAS unsigned* emask = (LAS unsigned*)(tot + 256 + 2048);
    for (int tb = blk; tb < NTOK / 128; tb += nblk) {
        __syncthreads();
        for (int e = wave * 8; e < wave * 8 + 8; ++e) { int t = 0, p = 0;
#pragma unroll
            for (int i = 0; i < 4; ++i) { const int j = lane + 64 * i; const int c = CNT[e * 256 + j]; t += c; p += (j < tb) ? c : 0; }
            t = __builtin_amdgcn_readlane((int)wave_scan_incl((unsigned)t), 63); p = __builtin_amdgcn_readlane((int)wave_scan_incl((unsigned)p), 63);
            if (lane == 0) { tot[e] = t; pre[e] = p; } }
        for (int i = tid; i < 1024; i += NTHREADS) { le[i] = RTE[(size_t)tb * 1024 + i]; lg[i] = RTG[(size_t)tb * 1024 + i]; }
        __syncthreads();
        if (tid == 0) { int acc = 0; for (int e = 0; e < 64; ++e) { base[e] = acc; acc += (tot[e] + 255) & ~255; } base[64] = acc; }
        __syncthreads();
        if (tid < 64) { const int e = tid; OFFS[e * 257 + tb] = base[e] + pre[e]; if (tb == NTOK / 128 - 1) OFFS[e * 257 + 256] = base[e] + tot[e]; }
        for (int i = tid; i < 256; i += NTHREADS) emask[i] = 0u;
        __syncthreads();
        for (int i = tid; i < 1024; i += NTHREADS) { const int tl = i >> 3; __hip_atomic_fetch_or(emask + le[i] * 4 + (tl >> 5), 1u << (tl & 31), __ATOMIC_RELAXED, __HIP_MEMORY_SCOPE_WORKGROUP); }
        __syncthreads();
        for (int i = tid; i < 1024; i += NTHREADS) {
            const int e = le[i], tl = i >> 3, wq = tl >> 5; const LAS unsigned* mk = emask + e * 4;
            int rank = __builtin_popcount(mk[wq] & ((1u << (tl & 31)) - 1u));
            rank += (wq > 0 ? __builtin_popcount(mk[0]) : 0) + (wq > 1 ? __builtin_popcount(mk[1]) : 0) + (wq > 2 ? __builtin_popcount(mk[2]) : 0);
            const int pos = base[e] + pre[e] + rank;
            STOK[pos] = tb * 128 + tl; SGATE[pos] = lg[i]; POS[(size_t)tb * 1024 + i] = pos;
        }
        for (int e = tb; e < 64; e += NTOK / 128) { const int r0 = base[e] + tot[e], r1 = base[e] + ((tot[e] + 255) & ~255);
            for (int r = r0 + tid; r < r1; r += NTHREADS) { STOK[r] = 0; SGATE[r] = 0.f; } }
        const int R0 = base[64];
        for (int t = tb * 128 + tid; t < tb * 128 + 128; t += NTHREADS) { STOK[R0 + t] = t; SGATE[R0 + t] = 1.0f; }
        if (tb == 0) {
            const int ntile = R0 / 256 + NTOK / 256;
            for (int pm = tid; pm < ntile; pm += NTHREADS) { int e = 64; if (pm < R0 / 256) { e = 0; while (e < 63 && pm * 256 >= base[e + 1]) ++e; } TILE[pm] = e; }
            if (tid == 0) { META[0] = ntile; META[1] = R0; }
        }
    }
    __syncthreads();
}

template <bool FINAL>
__device__ __forceinline__ void p_combine(const bf16_t* __restrict__ Y, const unsigned char* __restrict__ tab, const float* __restrict__ gt2, float* __restrict__ X1, const float* __restrict__ fgain,
                                          int gwave, int nwaves, int lane) {
    const int* POS = (const int*)(tab + T_POS); const float* RTG = (const float*)(tab + T_RTG); const int R0 = ((const int*)(tab + T_META))[1];
    const int half = FINAL ? 1 : 0;
    int npos[8]; float ngk[8];
#pragma unroll
    for (int k = 0; k < 8; ++k) { npos[k] = gwave < NTOK ? POS[(size_t)gwave * 8 + k] : 0; ngk[k] = gwave < NTOK ? RTG[(size_t)gwave * 8 + k] : 0.f; }
    for (int t = gwave; t < NTOK; t += nwaves) {
        const int b = t / SEQ;
        int pos[9]; float gk[9];
#pragma unroll
        for (int k = 0; k < 8; ++k) { pos[k] = npos[k]; gk[k] = ngk[k]; }
        pos[8] = R0 + t; gk[8] = 1.0f;
        { const int tn = t + nwaves < NTOK ? t + nwaves : t;
#pragma unroll
          for (int k = 0; k < 8; ++k) { npos[k] = POS[(size_t)tn * 8 + k]; ngk[k] = RTG[(size_t)tn * 8 + k]; } }
        float v[8];
#pragma unroll
        for (int j = 0; j < 8; ++j) v[j] = 0.f;
#pragma unroll
        for (int k = 0; k < 9; ++k) { const u32x4 w = *(const u32x4*)(Y + (size_t)pos[k] * 512 + lane * 8); const float gq = gk[k];
            v[0] += gq * bflo(w.x); v[1] += gq * bfhi(w.x); v[2] += gq * bflo(w.y); v[3] += gq * bfhi(w.y); v[4] += gq * bflo(w.z); v[5] += gq * bfhi(w.z); v[6] += gq * bflo(w.w); v[7] += gq * bfhi(w.w); }
        const int c0 = half * 512 + lane * 8;
        const float* gp = gt2 + (size_t)b * 6144 + c0;
        float* xp = X1 + (size_t)t * DM + c0;
        f32x4 x0 = *(const f32x4*)xp, x1v = *(const f32x4*)(xp + 4);
        const f32x4 g0 = *(const f32x4*)gp, g1 = *(const f32x4*)(gp + 4);
        x0 += g0 * (f32x4){v[0], v[1], v[2], v[3]}; x1v += g1 * (f32x4){v[4], v[5], v[6], v[7]};
        if (!FINAL) { *(f32x4*)xp = x0; *(f32x4*)(xp + 4) = x1v; }
        else {
            const float* xl = X1 + (size_t)t * DM + lane * 8;
            f32x4 l0 = *(const f32x4*)xl, l1 = *(const f32x4*)(xl + 4);
            float ss = 0.f;
#pragma unroll
            for (int j = 0; j < 4; ++j) ss += x0[j] * x0[j] + x1v[j] * x1v[j] + l0[j] * l0[j] + l1[j] * l1[j];
            ss = wave_sum(ss);
            const float rstd = rsqrtf(ss * (1.0f / DM) + EPS);
            const f32x4 fa = *(const f32x4*)(fgain + lane * 8), fb = *(const f32x4*)(fgain + lane * 8 + 4), fc = *(const f32x4*)(fgain + c0), fd = *(const f32x4*)(fgain + c0 + 4);
            float* ol = X1 + (size_t)t * DM + lane * 8;
            *(f32x4*)ol = l0 * rstd * fa; *(f32x4*)(ol + 4) = l1 * rstd * fb;
            *(f32x4*)xp = x0 * rstd * fc; *(f32x4*)(xp + 4) = x1v * rstd * fd;
        }
    }
}

#define PHASE3_BODY \
        { LAS unsigned* gw = (LAS unsigned*)(lds + LDS_AUX + 4096 + 256); const int half3 = wave >> 2; \
          __syncthreads(); if (tid < 8) gw[tid] = 0u; __syncthreads(); \
          GBar gb{gw + half3, 0u}; \
          if (half3 == 1) p3_token_prep(P, a.in[10], a.in[13], a.in[14], (bf16_t*)(regA + A_CKV), (bf16_t*)(regA + A_KIX), (float*)(regA + A_WIX), gwave, nwaves, lane); \
          for (int pair = blk; pair < 1024; pair += nblk) p3_dn_pair(lds, P, a.in[6], a.in[7], a.in[8], regA, regC, pair, tid, gb); \
          if (half3 == 0) p3_token_prep(P, a.in[10], a.in[13], a.in[14], (bf16_t*)(regA + A_CKV), (bf16_t*)(regA + A_KIX), (float*)(regA + A_WIX), gwave, nwaves, lane); }
#define PHASE4_BODY \
        for (int bh = blk; bh < 16; bh += nblk) p4_dn_scan(lds, regA, regC, bh, tid); \
        { LAS unsigned* gw = (LAS unsigned*)(lds + LDS_AUX + 4096 + 256);       \
          const int grp = wave >> 2; \
          __syncthreads(); if (tid < 8) gw[tid] = 0u; __syncthreads(); \
          GBar gb{gw + grp, 0u}; \
          const int hb = (int)(xb_xcc_id() & 3u);       \
          for (;;) { \
            if ((tid & 255) == 0) { unsigned got = 0xffffffffu; for (int k = 0; k < 4; ++k) { const int bb = (hb + k) & 3; const unsigned v = atomicAdd(ctl + CW_QUEUE + 64 * (4 * _rep + bb), 1u); if (v < 2048u) { got = (unsigned)bb * 2048u + v; break; } } gw[4 + grp] = got; } \
            gbar_sync(gb, lane); \
            const unsigned it = (unsigned)__builtin_amdgcn_readfirstlane((int)gw[4 + grp]); if (it == 0xffffffffu) break; \
            p4_attn_item(lds + grp * AT_GRP, (LAS unsigned short*)(lds + LDS_AUX), P, (const bf16_t*)(regA + A_CKV), (const bf16_t*)(regA + A_KIX), (const float*)(regA + A_WIX), (int)(it >> 11), (int)(it & 2047u), tid, gb); } }
#define PHASE5_BODY \
        p5_dn_finish(lds, P, a.in[9], regA, blk, nblk, tid); \
        xcd_barrier(bar); \
        { pg8::Gemm g{P, WoutT, NTOK, DM, KMIX, NP}; pg8::StaticOrder S; S.init(NTOK, DM, KMIX, WoutT, nblk, blk); pg8::EpiResidual E{x, X1, modv + 2048}; \
          pg8::gemm_phase<pg8::EpiResidual, pg8::StaticOrder, false>(lds, g, S, E); }
#define PHASE6_BODY \
        p6_norm_route(lds, X1, a.in[16], modp, a.in[3], a.in[17], a.in[18], H, tab, blk, nblk, tid); \
        p_expert_weights((LAS float*)lds, a.in[19], a.in[20], a.in[21], a.in[22], a.in[23], a.in[24], (bf16_t*)(ws + WS_WGU), (bf16_t*)(ws + WS_WDN), blk, nblk, tid);
#define PHASE7_BODY p7_place(lds, tab, blk, nblk, tid);
#define PHASE8_BODY \
        { const int* META = (const int*)(tab + T_META); \
          pg8::ExpertOrder S{(const int*)(tab + T_TILE), (const int*)(tab + T_STOK), (const bf16_t*)(ws + WS_WGU), 2 * META[0], nblk, blk, (size_t)512 * 1024 * 2, (size_t)256 * 1024 * 2, (size_t)0}; \
          pg8::Gemm g{H, nullptr, 0, 0, 1024, 1024}; pg8::EpiSwiglu E{(bf16_t*)(ws + WS_HB)}; \
          pg8::gemm_phase<pg8::EpiSwiglu, pg8::ExpertOrder, true>(lds, g, S, E); }
#define DOWN_HALF(hf) \
        { const int* META = (const int*)(tab + T_META); \
          pg8::ExpertOrder S{(const int*)(tab + T_TILE), nullptr, (const bf16_t*)(ws + WS_WDN), 2 * META[0], nblk, blk, (size_t)1024 * 256 * 2, (size_t)256 * 256 * 2, (size_t)(hf) * 512 * 256 * 2}; \
          int kd_ = 256; asm volatile("" : "+s"(kd_));       \
          pg8::Gemm g{(const bf16_t*)(ws + WS_HB), nullptr, 0, 0, kd_, 256}; pg8::EpiStoreBf16 E{(bf16_t*)(ws + WS_Y), 512}; \
          pg8::gemm_phase<pg8::EpiStoreBf16, pg8::ExpertOrder, false>(lds, g, S, E); }
#define PHASE9_BODY DOWN_HALF(0)
#define PHASE10_BODY p_combine<false>((const bf16_t*)(ws + WS_Y), tab, modv + 5120, X1, a.in[25], gwave, nwaves, lane);
#define PHASE11_BODY DOWN_HALF(1)
#define PHASE12_BODY p_combine<true>((const bf16_t*)(ws + WS_Y), tab, modv + 5120, X1, a.in[25], gwave, nwaves, lane);
constexpr int N_PHASES = 13;
struct Args { const float* in[26]; float* out; unsigned char* ws; int ph_lo, ph_hi; };
static_assert(sizeof(Args) == 26 * 8 + 8 + 8 + 8, "Args has no padding");

__global__ void __launch_bounds__(NTHREADS, 2) fwd_kernel(Args a) {
    extern __shared__ __attribute__((aligned(16))) unsigned char lds_raw[];
    LAS unsigned char* lds = (LAS unsigned char*)lds_raw;
    const int tid = threadIdx.x, lane = tid & 63, wave = __builtin_amdgcn_readfirstlane(tid >> 6);
    const int blk = blockIdx.x, nblk = gridDim.x, gwave = blk * NWAVES + wave, nwaves = nblk * NWAVES;
    unsigned char* ws = a.ws;
    unsigned* ctl = (unsigned*)(ws + WS_CTL);
    volatile LAS unsigned* misc = (volatile LAS unsigned*)(lds + LDS_MISC);
    if (tid < 64) misc[tid] = 0u;
    __syncthreads();
    const int lo = a.ph_lo, hi = a.ph_hi;
    XcdBarrier bar; bar.bar = ctl + CW_BAR; bar.x = 0; bar.st = misc;
    if (hi - lo > 1) bar = xcd_barrier_post(ctl + CW_BAR, misc);
#define IN(k) (lo <= (k) && (k) < hi)
#define SEAM(k) do { if (IN(k) && IN((k) + 1)) xcd_barrier(bar); } while (0)
#ifndef DUP_PHASE
#define DUP_PHASE -1
#endif
#define REP(k) for (int _rep = 0; _rep < ((DUP_PHASE == (k)) ? 2 : 1); ++_rep)

    const float* x = a.in[0];
    float* modp = (float*)(ws + WS_MODP); float* modv = (float*)(ws + WS_MODV);
    bf16_t* WinT = (bf16_t*)(ws + WS_WINT); bf16_t* WoutT = (bf16_t*)(ws + WS_WOUTT);
    bf16_t* H = (bf16_t*)(ws + WS_A); bf16_t* P = (bf16_t*)(ws + WS_P);
    unsigned char* regA = ws + WS_A; unsigned char* regC = ws + WS_C; unsigned char* tab = ws + WS_TAB;
    float* X1 = a.out;

    if (IN(0)) REP(0) {
        p0_mod_partials(a.in[1], a.in[2], modp, gwave, nwaves, lane);
        p0_weights((LAS float*)lds, a.in[5], a.in[11], a.in[12], a.in[15], WinT, WoutT, blk, nblk, tid);
    }
    SEAM(0);
    if (IN(1)) REP(1) {
        for (int idx = blk * NTHREADS + tid; idx < 4 * 6144; idx += nblk * NTHREADS) { const int b = idx / 6144, col = idx % 6144; float s = a.in[3][col];
#pragma unroll
            for (int ks = 0; ks < 8; ++ks) s += modp[(size_t)(ks * 4 + b) * 6144 + col];
            modv[idx] = s; }
        p1_norm((LAS float*)lds, x, a.in[4], modp, a.in[3], 0, H, blk, nblk, tid);
    }
    SEAM(1);
    if (IN(2)) {
#define PHASE2_BODY { pg8::Gemm g{H, WinT, NTOK, NP, 1024, 1024}; pg8::StaticOrder S; S.init(NTOK, NP, 1024, WinT, nblk, blk); pg8::EpiStoreBf16 E{P, NP}; pg8::gemm_phase<pg8::EpiStoreBf16, pg8::StaticOrder, false>(lds, g, S, E); }
        PHASE2_BODY
        if (DUP_PHASE == 2) { PHASE2_BODY }
    }
    SEAM(2);
    if (IN(3)) REP(3) {
        PHASE3_BODY
    }
    SEAM(3);
    if (IN(4)) REP(4) {
        PHASE4_BODY
    }
    SEAM(4);
    if (IN(5)) {
        PHASE5_BODY
        if (DUP_PHASE == 5) { PHASE5_BODY }
    }
    SEAM(5);
    if (IN(6)) REP(6) {
        PHASE6_BODY
    }
    SEAM(6);
    if (IN(7)) REP(7) {
        PHASE7_BODY
    }
    SEAM(7);
    if (IN(8)) {
        PHASE8_BODY
        if (DUP_PHASE == 8) { PHASE8_BODY }
    }
    SEAM(8);
    if (IN(9)) {
        PHASE9_BODY
        if (DUP_PHASE == 9) { PHASE9_BODY }
    }
    SEAM(9);
    if (IN(10)) {
        PHASE10_BODY
    }
    SEAM(10);
    if (IN(11)) {
        PHASE11_BODY
    }
    SEAM(11);
    if (IN(12)) {
        PHASE12_BODY
    }
#undef IN
#undef SEAM
}

extern "C" void kernel_launch(void* const* d_in, const int* in_sizes, int n_in, void* d_out, int out_size, void* d_ws, size_t ws_size, hipStream_t stream) {
    static int grid = 0;
    if (grid == 0) {
        if (n_in != 26 || out_size != NTOK * DM || ws_size < WS_END || ws_size < WS_TAB + T_END) { fprintf(stderr, "kernel_launch: unexpected shapes (n_in %d out %d ws %zu need %zu)\n", n_in, out_size, ws_size, (size_t)WS_END); grid = -1; return; }
        int dev = 0, cus = 0, per_cu = 0;
        if (hipGetDevice(&dev) != hipSuccess || hipDeviceGetAttribute(&cus, hipDeviceAttributeMultiprocessorCount, dev) != hipSuccess) { grid = -1; return; }
        if (hipFuncSetAttribute((const void*)fwd_kernel, hipFuncAttributeMaxDynamicSharedMemorySize, LDS_BYTES) != hipSuccess) { fprintf(stderr, "kernel_launch: hipFuncSetAttribute failed\n"); grid = -1; return; }
        if (hipOccupancyMaxActiveBlocksPerMultiprocessor(&per_cu, (const void*)fwd_kernel, NTHREADS, LDS_BYTES) != hipSuccess || per_cu < 1) { fprintf(stderr, "kernel_launch: occupancy query reports %d\n", per_cu); }
        (void)hipGetLastError();
        grid = cus;
    }
    if (grid < 0) return;
    (void)hipMemsetAsync((char*)d_ws + WS_CTL, 0, CTL_BYTES, stream);
    Args a{};
    for (int i = 0; i < 26; ++i) a.in[i] = (const float*)d_in[i];
    a.out = (float*)d_out; a.ws = (unsigned char*)d_ws;
    a.ph_lo = 0; a.ph_hi = N_PHASES;
    hipLaunchKernelGGL(fwd_kernel, dim3(grid), dim3(NTHREADS), LDS_BYTES, stream, a);
}
```

```cpp
#include <hip/hip_runtime.h>
#include <cstdio>
#include <cstdint>

constexpr int NB = 4, SEQ = 8192, DM = 1024, NTOK = NB * SEQ;
constexpr int CHUNK = 64, NCH = SEQ / CHUNK;
constexpr int DIN = 3148;
constexpr int NP = 3840;
constexpr int PC_Q = 0, PC_K = 512, PC_V = 1024, PC_Z = 1536, PC_QLAT = 2048, PC_CKV = 3072, PC_QIX = 3328, PC_KIX = 3584, PC_B = 3648, PC_A = 3652, PC_WIX = 3656, PC_END = 3660;
constexpr int WC_B = 2048, WC_A = 2052, WC_QSA = 2056, WC_CKV = 2568, WC_QIX = 2824, WC_KIX = 3080, WC_WIX = 3144;
constexpr int KMIX = 1536;
constexpr int NEXP = 64, NEXP1 = 65, TOPK = 8, DEXP = 256;
constexpr int NTHREADS = 512, NWAVES = 8;
constexpr float EPS = 1e-6f;
constexpr int NASSIGN = NTOK * TOPK;
constexpr int HB_ROWS = NASSIGN + NEXP * 256 + NTOK;

typedef unsigned short bf16_t;
constexpr int XB_LD = 2048, XB_X2 = 1024;
constexpr int Y_LD = 640, Y_SC = 512;
constexpr float Y_QMAX = 224.0f;
#define LAS __attribute__((address_space(3)))
typedef short bf16x8 __attribute__((ext_vector_type(8)));
typedef short bf16x4 __attribute__((ext_vector_type(4)));
typedef float f32x4 __attribute__((ext_vector_type(4)));
typedef float f32x2 __attribute__((ext_vector_type(2)));
typedef unsigned u32x4 __attribute__((ext_vector_type(4)));
typedef unsigned u32x2 __attribute__((ext_vector_type(2)));

constexpr size_t al256(size_t x) { return (x + 255) & ~(size_t)255; }
constexpr size_t WS_CTL    = 0;
constexpr size_t CTL_BYTES = 65536;
constexpr size_t WS_MODP   = WS_CTL + CTL_BYTES;
constexpr size_t WS_MODV   = WS_MODP + al256((size_t)8 * 4 * 6144 * 4);
constexpr size_t WS_WINT   = WS_MODV + al256((size_t)4 * 6144 * 4);
constexpr size_t WS_WOUTT  = WS_WINT + al256((size_t)NP * 1024 * 2);
constexpr size_t WS_A      = WS_WOUTT + al256((size_t)1024 * KMIX * 2);
constexpr size_t A_BYTES   = (size_t)NTOK * 1024 * 2;
constexpr size_t WS_P      = WS_A + A_BYTES;
constexpr size_t P_BYTES   = (size_t)NTOK * NP * 2;
constexpr size_t WS_C      = WS_P + P_BYTES;
constexpr size_t C_BYTES   = (size_t)118 * 1024 * 1024;
constexpr size_t WS_END    = WS_C + C_BYTES;
static_assert(WS_END <= (size_t)512 * 1024 * 1024, "workspace map exceeds 512 MiB");
constexpr size_t A_CKV  = 0;
constexpr size_t A_KIX  = A_CKV + (size_t)NTOK * 256 * 2;
constexpr size_t A_BETA = A_KIX + (size_t)NTOK * 64 * 2;
constexpr size_t A_GLOG = A_BETA + (size_t)NTOK * 4 * 4;
constexpr size_t A_WIX  = A_GLOG + (size_t)NTOK * 4 * 4;
constexpr size_t A_UT   = A_WIX + (size_t)NTOK * 4 * 4;
constexpr size_t A_GTOT = A_UT + (size_t)2048 * 128 * 64 * 2;
static_assert(A_GTOT + 2048 * 4 <= A_BYTES, "region A map");
constexpr size_t C_WM    = 0;
constexpr size_t C_QDEC  = C_WM + (size_t)2048 * 64 * 128 * 2;
constexpr size_t C_KDECT = C_QDEC + (size_t)2048 * 64 * 128 * 2;
constexpr size_t C_QK    = C_KDECT + (size_t)2048 * 64 * 128 * 2;
static_assert(C_QK + (size_t)2048 * 64 * 64 * 2 <= C_BYTES, "region C map (DeltaNet)");
constexpr size_t WS_Y    = WS_A;
constexpr size_t Y_BYTES = (size_t)HB_ROWS * 512 * 2;
constexpr size_t WS_WGU  = WS_P;
constexpr size_t WS_HB   = WS_Y + Y_BYTES;
constexpr size_t WS_WDN  = WS_HB + (size_t)HB_ROWS * 256 * 2;
constexpr size_t WS_TAB  = WS_WDN + (size_t)NEXP1 * 1024 * 256 * 2;
static_assert(WS_WGU + (size_t)NEXP1 * 512 * 1024 * 2 <= WS_HB, "gate/up weights end before HB starts");
static_assert(WS_END <= WS_WDN, "down weights / tables lie beyond every early-stage buffer");
constexpr size_t T_RTE   = 0;
constexpr size_t T_RTG   = T_RTE + (size_t)NTOK * 8 * 4;
constexpr size_t T_POS   = T_RTG + (size_t)NTOK * 8 * 4;
constexpr size_t T_STOK  = T_POS + (size_t)NTOK * 8 * 4;
constexpr size_t T_SGATE = T_STOK + (size_t)HB_ROWS * 4;
constexpr size_t T_CNT   = al256(T_SGATE + (size_t)HB_ROWS * 4);
constexpr size_t T_OFFS  = T_CNT + 64 * 256 * 4;
constexpr size_t T_TILE  = al256(T_OFFS + 64 * 257 * 4);
constexpr size_t T_META  = T_TILE + (size_t)(HB_ROWS / 256 + 1) * 4;
constexpr size_t T_END   = T_META + 64;
static_assert(WS_TAB + T_END <= (size_t)512 * 1024 * 1024, "late-stage workspace map exceeds 512 MiB");
constexpr int CW_BAR = 0;
constexpr int CW_QUEUE = 4096;
constexpr int CW_FLAG = 8192;

constexpr int LDS_MAIN = 0;
constexpr int LDS_MAIN_BYTES = 149504;
constexpr int LDS_AUX = LDS_MAIN_BYTES;
constexpr int LDS_AUX_BYTES = 6144;
constexpr int LDS_MISC = LDS_AUX + LDS_AUX_BYTES;
constexpr int LDS_BYTES = LDS_MISC + 256;
static_assert(LDS_BYTES <= 160 * 1024, "LDS");

__device__ __forceinline__ unsigned cvt_pk_bf16(float lo, float hi) { unsigned r; asm volatile("v_cvt_pk_bf16_f32 %0, %1, %2" : "=v"(r) : "v"(lo), "v"(hi)); return r; }
__device__ __forceinline__ unsigned cvt_pk_bf16_mfma(float lo, float hi) { unsigned r; asm volatile("s_nop 7\n\ts_nop 7\n\tv_cvt_pk_bf16_f32 %0, %1, %2" : "=v"(r) : "v"(lo), "v"(hi)); return r; }
__device__ __forceinline__ bf16_t f2bf(float f) { return (bf16_t)(cvt_pk_bf16(f, 0.f) & 0xffffu); }
__device__ __forceinline__ float bf2f(unsigned h) { return __uint_as_float(h << 16); }
__device__ __forceinline__ float bflo(unsigned w) { return __uint_as_float(w << 16); }
__device__ __forceinline__ float bfhi(unsigned w) { return __uint_as_float(w & 0xffff0000u); }
#define DPP_I(x, ctrl) __builtin_amdgcn_update_dpp(0, (int)(x), (ctrl), 0xf, 0xf, false)
#define DPP_F(x, ctrl) __int_as_float(__builtin_amdgcn_update_dpp(0, __float_as_int(x), (ctrl), 0xf, 0xf, false))
constexpr int DPP_XOR1 = 0xB1, DPP_XOR2 = 0x4E, DPP_HMIRROR = 0x141, DPP_MIRROR = 0x140;
__device__ __forceinline__ unsigned wave_scan_incl(unsigned v) {
    v += (unsigned)__builtin_amdgcn_update_dpp(0, (int)v, 0x111, 0xf, 0xf, false);
    v += (unsigned)__builtin_amdgcn_update_dpp(0, (int)v, 0x112, 0xf, 0xf, false);
    v += (unsigned)__builtin_amdgcn_update_dpp(0, (int)v, 0x114, 0xf, 0xf, false);
    v += (unsigned)__builtin_amdgcn_update_dpp(0, (int)v, 0x118, 0xf, 0xf, false);
    v += (unsigned)__builtin_amdgcn_update_dpp(0, (int)v, 0x142, 0xa, 0xf, false);
    v += (unsigned)__builtin_amdgcn_update_dpp(0, (int)v, 0x143, 0xc, 0xf, false);
    return v;
}
__device__ __forceinline__ float wave_scan_incl_f(float v) {
    v += __int_as_float(__builtin_amdgcn_update_dpp(0, __float_as_int(v), 0x111, 0xf, 0xf, false));
    v += __int_as_float(__builtin_amdgcn_update_dpp(0, __float_as_int(v), 0x112, 0xf, 0xf, false));
    v += __int_as_float(__builtin_amdgcn_update_dpp(0, __float_as_int(v), 0x114, 0xf, 0xf, false));
    v += __int_as_float(__builtin_amdgcn_update_dpp(0, __float_as_int(v), 0x118, 0xf, 0xf, false));
    v += __int_as_float(__builtin_amdgcn_update_dpp(0, __float_as_int(v), 0x142, 0xa, 0xf, false));
    v += __int_as_float(__builtin_amdgcn_update_dpp(0, __float_as_int(v), 0x143, 0xc, 0xf, false));
    return v;
}
__device__ __forceinline__ float oct_sum(float x) { x += DPP_F(x, DPP_XOR1); x += DPP_F(x, DPP_XOR2); x += DPP_F(x, DPP_HMIRROR); return x; }
__device__ __forceinline__ float oct_max(float x) { x = fmaxf(x, DPP_F(x, DPP_XOR1)); x = fmaxf(x, DPP_F(x, DPP_XOR2)); x = fmaxf(x, DPP_F(x, DPP_HMIRROR)); return x; }
__device__ __forceinline__ float row16_max_f(float x) { x = oct_max(x); x = fmaxf(x, DPP_F(x, DPP_MIRROR)); return x; }
__device__ __forceinline__ float row16_sum(float x) { x = oct_sum(x); x += DPP_F(x, DPP_MIRROR); return x; }
__device__ __forceinline__ unsigned row16_max_u(unsigned x) { unsigned t;
    t = (unsigned)DPP_I(x, DPP_XOR1); x = t > x ? t : x; t = (unsigned)DPP_I(x, DPP_XOR2); x = t > x ? t : x;
    t = (unsigned)DPP_I(x, DPP_HMIRROR); x = t > x ? t : x; t = (unsigned)DPP_I(x, DPP_MIRROR); x = t > x ? t : x; return x; }
__device__ __forceinline__ float xrow_sum(float x) {
    const auto r = __builtin_amdgcn_permlane16_swap(__float_as_uint(x), __float_as_uint(x), false, false); x = __uint_as_float(r[0]) + __uint_as_float(r[1]);
    const auto q = __builtin_amdgcn_permlane32_swap(__float_as_uint(x), __float_as_uint(x), false, false); return __uint_as_float(q[0]) + __uint_as_float(q[1]);
}
__device__ __forceinline__ float xrow_max(float x) {
    const auto r = __builtin_amdgcn_permlane16_swap(__float_as_uint(x), __float_as_uint(x), false, false); x = fmaxf(__uint_as_float(r[0]), __uint_as_float(r[1]));
    const auto q = __builtin_amdgcn_permlane32_swap(__float_as_uint(x), __float_as_uint(x), false, false); return fmaxf(__uint_as_float(q[0]), __uint_as_float(q[1]));
}
__device__ __forceinline__ float wave_sum(float v) { return xrow_sum(row16_sum(v)); }
struct GBar { LAS unsigned* cnt; unsigned target; };
__device__ __forceinline__ void gbar_sync(GBar& gb, int lane) {
    asm volatile("s_waitcnt lgkmcnt(0)" ::: "memory");
    gb.target += 4u;
    if (lane == 0) __hip_atomic_fetch_add(gb.cnt, 1u, __ATOMIC_RELAXED, __HIP_MEMORY_SCOPE_WORKGROUP);
    for (unsigned spin = 0;; ++spin) {
        const unsigned v = (unsigned)__builtin_amdgcn_readfirstlane((int)__hip_atomic_load(gb.cnt, __ATOMIC_RELAXED, __HIP_MEMORY_SCOPE_WORKGROUP));
        if ((int)(v - gb.target) >= 0 || spin > (1u << 26)) break;
        __builtin_amdgcn_s_sleep(1);
    }
    asm volatile("" ::: "memory");
}

__device__ __forceinline__ float silu_f(float x) { return x * __builtin_amdgcn_rcpf(1.0f + __expf(-x)); }
__device__ __forceinline__ float sigmoid_f(float x) { return __builtin_amdgcn_rcpf(1.0f + __expf(-x)); }

#define XB_TMO      128
#define XB_XCNT(j)  (256  + 64 * (j))
#define XB_XSUB(j)  (1280 + 64 * (j))
#define XB_XGEN(j)  (2304 + 64 * (j))
#define XB_TOP      3328
#define XB_TOPGEN   3392
#define XCD_BAR_WORDS 3456
#define XB_SPIN_CAP (1u << 18)

__device__ __forceinline__ unsigned xb_ld(unsigned* p)              { return __hip_atomic_load(p, __ATOMIC_RELAXED, __HIP_MEMORY_SCOPE_AGENT); }
__device__ __forceinline__ unsigned xb_add(unsigned* p, unsigned v) { return __hip_atomic_fetch_add(p, v, __ATOMIC_RELAXED, __HIP_MEMORY_SCOPE_AGENT); }
__device__ __forceinline__ unsigned xb_xcc_id() { return (unsigned)__builtin_amdgcn_s_getreg((3 << 11) | 20) & 0xFu; }
#define XB_SPIN(cond, bar) do { unsigned _sp = 0; while (cond) { __builtin_amdgcn_s_sleep(1); \
    if ((++_sp & 255u) == 0u) { if (xb_ld(&(bar)[XB_TMO])) break; if (_sp > XB_SPIN_CAP) { atomicAdd(&(bar)[XB_TMO], 1u); break; } } } } while (0)

struct XcdBarrier {
    unsigned* bar; unsigned x;
    volatile LAS unsigned* st;
};

__device__ __forceinline__ XcdBarrier xcd_barrier_post(unsigned* bar, volatile LAS unsigned* st) {
    XcdBarrier b; b.bar = bar; b.x = xb_xcc_id(); b.st = st;
    if (threadIdx.x == 0) (void)xb_add(&bar[XB_XCNT(b.x)], 1u);
    return b;
}
__device__ __forceinline__ void xcd_barrier_complete(unsigned* bar, unsigned x, unsigned& nloc, unsigned& nx) {
    const unsigned G = gridDim.x * gridDim.y * gridDim.z;
    unsigned sum, cnt, mine, sp = 0u;
    for (;;) {
        sum = 0u; cnt = 0u; mine = 0u;
#pragma unroll
        for (unsigned j = 0; j < 16; ++j) { const unsigned c = xb_ld(&bar[XB_XCNT(j)]); sum += c; cnt += (c > 0u) ? 1u : 0u; mine = (j == x) ? c : mine; }
        if (sum == G) break;
        __builtin_amdgcn_s_sleep(1);
        if ((++sp & 255u) == 0u) { if (xb_ld(&bar[XB_TMO])) break; if (sp > XB_SPIN_CAP) { atomicAdd(&bar[XB_TMO], 1u); break; } }
    }
    nloc = mine > 0u ? mine : 1u; nx = cnt > 0u ? cnt : 1u;
}

__device__ __forceinline__ void xcd_barrier(const XcdBarrier& b) {
    asm volatile("s_waitcnt vmcnt(0)" ::: "memory");
    __syncthreads();
    if (threadIdx.x == 0) {
        unsigned* bar = b.bar;
        __builtin_amdgcn_s_waitcnt(0);
        unsigned nloc = b.st[0], nx = b.st[1];
        if (nloc == 0u) { xcd_barrier_complete(bar, b.x, nloc, nx); b.st[0] = nloc; b.st[1] = nx; }
        const unsigned old = xb_add(&bar[XB_XSUB(b.x)], 1u);
        const unsigned gen = old / nloc;
        if (old + 1u == (gen + 1u) * nloc) {
            __builtin_amdgcn_fence(__ATOMIC_RELEASE, "agent");
            asm volatile("s_waitcnt vmcnt(0)" ::: "memory");
            const unsigned og = xb_add(&bar[XB_TOP], 1u);
            const unsigned tg = og / nx;
            if (og + 1u == (tg + 1u) * nx) xb_add(&bar[XB_TOPGEN], 1u);
            else XB_SPIN(xb_ld(&bar[XB_TOPGEN]) == tg, bar);
            __builtin_amdgcn_fence(__ATOMIC_ACQUIRE, "agent");
            xb_add(&bar[XB_XGEN(b.x)], 1u);
            asm volatile("s_waitcnt vmcnt(0)" ::: "memory");
        } else {
            XB_SPIN(xb_ld(&bar[XB_XGEN(b.x)]) == gen, bar);
            __builtin_amdgcn_fence(__ATOMIC_ACQUIRE, "agent");
            asm volatile("s_waitcnt vmcnt(0)" ::: "memory");
        }
    }
    __syncthreads();
}
namespace pg8 {
#define PG8_LAS __attribute__((address_space(3)))
constexpr int BM = 256, BK = 64, HALF = 128, HTB = HALF * BK * 2  , STAGE_BYTES = 8 * HTB, NXCD = 8, WGM = 8;

__host__ __device__ __forceinline__ int lds_byte(int r, int c) { const int st = (r >> 4) * 2 + (c >> 5), rr = r & 15, cc = c & 31, ob = rr * 64 + cc * 2; return st * 1024 + (ob ^ (((ob >> 9) & 1) << 5)); }
__host__ __device__ __forceinline__ void stage_rc(int b, int& R, int& C) { const int st = b / 1024, sb = b % 1024, swz = sb ^ (((sb >> 9) & 1) << 5); R = (st >> 1) * 16 + swz / 64; C = (st & 1) * 32 + (swz % 64) / 2; }
__host__ __device__ __forceinline__ int perm32(int rho) { const int n = rho >> 4, i = rho & 15; return 8 * (i >> 2) + 4 * n + (i & 3); }

struct Unit { int pm, pn, e, h; };
struct Unit_unused_ { int x; };
struct Gemm { const bf16_t* A; const bf16_t* Bt; int M, N, K, lda; };

struct StaticOrder {
    int nM, nN, nwg, G, c; const bf16_t* Bt; size_t tstepB;
    __device__ void init(int M, int N, int K, const bf16_t* Bt_, int G_, int c_) { nM = M / BM; nN = N / BM; nwg = nM * nN; G = G_; c = c_; Bt = Bt_; tstepB = (size_t)BM * K * 2; }
    __device__ bool next(int i, Unit& u) const {
        const int nfull = nwg / G, R = nwg - nfull * G; long L; int hh = 0;
        if (i < nfull) L = (long)i * G + c;
        else if (i == nfull && R > 0) { if (2 * R <= G) { if (c >= 2 * R) return false; L = (long)nfull * G + (c % R); hh = 1 + c / R; } else { if (c >= R) return false; L = (long)nfull * G + c; } }
        else return false;
        u.h = hh;
        int wgid = (int)L; { const int q = nwg / NXCD, r = nwg % NXCD, xcd = wgid % NXCD, off = wgid / NXCD; wgid = (xcd < r ? xcd * (q + 1) : r * (q + 1) + (xcd - r) * q) + off; }
        const int nig = WGM * nN, gid = wgid / nig, fm = gid * WGM, gsz = (nM - fm) < WGM ? (nM - fm) : WGM;
        u.pm = fm + ((wgid % nig) % gsz); u.pn = (wgid % nig) / gsz; u.e = 0; return true;
    }
    __device__ __forceinline__ const char* b_base(const Unit& u) const { return (const char*)Bt + (size_t)u.pn * tstepB; }
    __device__ __forceinline__ const int* rows(const Unit& u) const { return nullptr; }
};
struct ExpertOrder {
    const int* tile_e; const int* srows; const bf16_t* W; int n_units, G, c; size_t estep, tstepB, boff;
    __device__ bool next(int i, Unit& u) const {
        const long L = (long)i * G + c; if (L >= ((n_units + 15) & ~15)) return false;
        const int grp = (int)(L >> 4), r = (int)(L & 15); int pm = grp * 8 + (r & 7); const int ntile = n_units >> 1; pm = pm < ntile ? pm : ntile - 1;
        u.pm = pm; u.pn = r >> 3; u.e = tile_e[pm]; u.h = 0; return true;
    }
    __device__ __forceinline__ const char* b_base(const Unit& u) const { return (const char*)W + (size_t)u.e * estep + boff + (size_t)u.pn * tstepB; }
    __device__ __forceinline__ const int* rows(const Unit& u) const { return srows + (size_t)u.pm * BM; }
};

template <class Epi, class Sched, bool GATHER>
__device__ __forceinline__ void gemm_phase(PG8_LAS unsigned char* lds, const Gemm g, const Sched& S, const Epi& E) {
    const int tid = threadIdx.x, wid = __builtin_amdgcn_readfirstlane(tid >> 6), lane = tid & 63, wr = wid >> 2, wc = wid & 3, fr = lane & 15, fq = lane >> 4;
    const int K = g.K, nt = K / BK, lda = g.lda;
    unsigned voffB[2]; int RA[2], CA[2];
#pragma unroll
    for (int i = 0; i < 2; ++i) { int R, C; stage_rc(tid * 16 + i * 8192, R, C); const int Rb = Epi::PERM ? ((R & ~31) + perm32(R & 31)) : R;
        RA[i] = R; CA[i] = C; voffB[i] = (unsigned)(Rb * K + C) * 2u; }
    const size_t kstep = (size_t)(BK * 2);
    const size_t hstepB = (size_t)HALF * K * 2;
    const size_t tstepA = (size_t)BM * lda * 2;
    const unsigned ldsw = (unsigned)wid * 1024u;
    const int aoff = lds_byte(wr * 64 + fr, fq * 8), boff = lds_byte(wc * 32 + fr, fq * 8);
#define PG8_SA(b, h) (((b) * 2 + (h)) * HTB)
#define PG8_SB(b, h) ((4 + (b) * 2 + (h)) * HTB)
#define PG8_STAGE(bufoff, gbase, voff) do { _Pragma("unroll") for (int _i = 0; _i < 2; ++_i) \
        __builtin_amdgcn_global_load_lds((const unsigned*)((const char*)(gbase) + (voff)[_i]), (PG8_LAS unsigned*)(lds + (bufoff) + ldsw + _i * 8192), 16, 0, 0); } while (0)
#define PG8_LDA(dst, b, h) do { _Pragma("unroll") for (int m = 0; m < 4; ++m) _Pragma("unroll") for (int k = 0; k < 2; ++k) dst[m][k] = *(const PG8_LAS bf16x8*)(lds + PG8_SA(b, h) + aoff + m * 2048 + k * 1024); } while (0)
#define PG8_LDB(dst, b, h) do { _Pragma("unroll") for (int n = 0; n < 2; ++n) _Pragma("unroll") for (int k = 0; k < 2; ++k) dst[n][k] = *(const PG8_LAS bf16x8*)(lds + PG8_SB(b, h) + boff + n * 2048 + k * 1024); } while (0)
#define PG8_MMA(ai, bj, At, Bt) do { __builtin_amdgcn_s_setprio(1); _Pragma("unroll") for (int m = 0; m < 4; ++m) _Pragma("unroll") for (int n = 0; n < 2; ++n) _Pragma("unroll") for (int k = 0; k < 2; ++k) \
        acc[ai][bj][m][n] = __builtin_amdgcn_mfma_f32_16x16x32_bf16(Bt[n][k], At[m][k], acc[ai][bj][m][n], 0, 0, 0); __builtin_amdgcn_s_setprio(0); } while (0)
#define PG8_WAIT_V(n) asm volatile("s_waitcnt vmcnt(" #n ")" ::: "memory")
#define PG8_WAIT_L(n) asm volatile("s_waitcnt lgkmcnt(" #n ")" ::: "memory")
#define PG8_BAR __builtin_amdgcn_s_barrier()
#define PG8_SCHED __builtin_amdgcn_sched_barrier(0)
#define PG8_AOFFS(va, u) do { if (GATHER) { const int* _rw = S.rows(u); _Pragma("unroll") for (int _h = 0; _h < 2; ++_h) _Pragma("unroll") for (int _i = 0; _i < 2; ++_i) \
            va[_h][_i] = ((unsigned)_rw[_h * HALF + RA[_i]] * (unsigned)lda + (unsigned)CA[_i]) * 2u; } \
        else { _Pragma("unroll") for (int _h = 0; _h < 2; ++_h) _Pragma("unroll") for (int _i = 0; _i < 2; ++_i) va[_h][_i] = ((unsigned)(_h * HALF + RA[_i]) * (unsigned)lda + (unsigned)CA[_i]) * 2u; } } while (0)
    Unit cur, nxt; int ui = 0;
    if (!S.next(0, cur)) return;
    f32x4 acc[2][2][4][2];
#pragma unroll
    for (int a = 0; a < 2; ++a)
#pragma unroll
        for (int b = 0; b < 2; ++b)
#pragma unroll
            for (int m = 0; m < 4; ++m)
#pragma unroll
                for (int n = 0; n < 2; ++n) acc[a][b][m][n] = (f32x4){0.f, 0.f, 0.f, 0.f};
    bf16x8 At[4][2], B0[2][2], B1[2][2];
    unsigned cva[2][2], nva[2][2];
    PG8_AOFFS(cva, cur);
    const char* cA = (const char*)g.A + (GATHER ? (size_t)0 : (size_t)cur.pm * tstepA); const char* cB = S.b_base(cur);
    PG8_STAGE(PG8_SB(0, 0), cB, voffB); PG8_STAGE(PG8_SA(0, 0), cA, cva[0]); PG8_STAGE(PG8_SB(0, 1), cB + hstepB, voffB); PG8_STAGE(PG8_SA(0, 1), cA, cva[1]);
    if (wr == 1) PG8_BAR;
    PG8_WAIT_V(4); PG8_BAR;
    PG8_STAGE(PG8_SB(1, 0), cB + kstep, voffB); PG8_STAGE(PG8_SA(1, 0), cA + kstep, cva[0]); PG8_STAGE(PG8_SB(1, 1), cB + hstepB + kstep, voffB);
    PG8_WAIT_V(6); PG8_BAR;
    for (;;) {
        const bool has_next = S.next(ui + 1, nxt);
        const char* nA = has_next ? (const char*)g.A + (GATHER ? (size_t)0 : (size_t)nxt.pm * tstepA) : cA; const char* nB = has_next ? S.b_base(nxt) : cB;
#pragma unroll
        for (int _h = 0; _h < 2; ++_h)
#pragma unroll
            for (int _i = 0; _i < 2; ++_i) nva[_h][_i] = cva[_h][_i];
        constexpr bool CANSPLIT = !GATHER && Epi::PERM && sizeof(Sched) < 64;
        const int hsel = CANSPLIT ? cur.h : 0;
        for (int t = 0; t < nt; t += 2) {
            const bool last = (t == nt - 2);
            if (GATHER && last && has_next) PG8_AOFFS(nva, nxt);
            const char* a1 = cA + (size_t)(t + 1) * kstep;
            const char* a2 = last ? nA : cA + (size_t)(t + 2) * kstep; const char* b2 = last ? nB : cB + (size_t)(t + 2) * kstep;
            const char* a3 = a2 + kstep; const char* b3 = b2 + kstep;
            unsigned va2[2][2];
#pragma unroll
            for (int _h = 0; _h < 2; ++_h)
#pragma unroll
                for (int _i = 0; _i < 2; ++_i) va2[_h][_i] = (GATHER && last) ? nva[_h][_i] : cva[_h][_i];
            PG8_LDB(B0, 0, 0); PG8_SCHED; PG8_LDA(At, 0, 0); PG8_STAGE(PG8_SA(1, 1), a1, cva[1]);
            PG8_WAIT_L(8); PG8_BAR; PG8_WAIT_L(0); if (hsel != 2) PG8_MMA(0, 0, At, B0); PG8_BAR; PG8_SCHED;
            PG8_LDB(B1, 0, 1); PG8_STAGE(PG8_SB(0, 0), b2, voffB);
            PG8_BAR; PG8_WAIT_L(0); if (hsel != 2) PG8_MMA(0, 1, At, B1); PG8_BAR;
            PG8_LDA(At, 0, 1); PG8_STAGE(PG8_SA(0, 0), a2, va2[0]);
            PG8_BAR; PG8_WAIT_L(0); if (hsel != 1) PG8_MMA(1, 0, At, B0); PG8_BAR; PG8_SCHED;
            PG8_STAGE(PG8_SB(0, 1), b2 + hstepB, voffB);
            PG8_WAIT_V(6); PG8_BAR; if (hsel != 1) PG8_MMA(1, 1, At, B1); PG8_BAR;
            PG8_LDB(B0, 1, 0); PG8_SCHED; PG8_LDA(At, 1, 0); PG8_STAGE(PG8_SA(0, 1), a2, va2[1]);
            PG8_WAIT_L(8); PG8_BAR; PG8_WAIT_L(0); if (hsel != 2) PG8_MMA(0, 0, At, B0); PG8_BAR; PG8_SCHED;
            PG8_LDB(B1, 1, 1); PG8_STAGE(PG8_SB(1, 0), b3, voffB);
            PG8_BAR; PG8_WAIT_L(0); if (hsel != 2) PG8_MMA(0, 1, At, B1); PG8_BAR;
            PG8_LDA(At, 1, 1); PG8_STAGE(PG8_SA(1, 0), a3, va2[0]);
            PG8_BAR; PG8_WAIT_L(0); if (hsel != 1) PG8_MMA(1, 0, At, B0); PG8_BAR; PG8_SCHED;
            PG8_STAGE(PG8_SB(1, 1), b3 + hstepB, voffB);
            PG8_WAIT_V(6); PG8_BAR; if (hsel != 1) PG8_MMA(1, 1, At, B1); PG8_BAR;
        }
        E(acc, cur, wr, wc, fr, fq);
        if (!has_next) break;
#pragma unroll
        for (int a = 0; a < 2; ++a)
#pragma unroll
            for (int b = 0; b < 2; ++b)
#pragma unroll
                for (int m = 0; m < 4; ++m)
#pragma unroll
                    for (int n = 0; n < 2; ++n) acc[a][b][m][n] = (f32x4){0.f, 0.f, 0.f, 0.f};
        cur = nxt; cA = nA; cB = nB; ++ui;
#pragma unroll
        for (int _h = 0; _h < 2; ++_h)
#pragma unroll
            for (int _i = 0; _i < 2; ++_i) cva[_h][_i] = nva[_h][_i];
    }
    PG8_WAIT_V(0);
    if (wr == 0) PG8_BAR;
    PG8_BAR;
#undef PG8_SA
#undef PG8_SB
#undef PG8_STAGE
#undef PG8_LDA
#undef PG8_LDB
#undef PG8_MMA
#undef PG8_WAIT_V
#undef PG8_WAIT_L
#undef PG8_BAR
#undef PG8_SCHED
#undef PG8_AOFFS
}

struct EpiStoreBf16 {
    static constexpr bool PERM = true;
    bf16_t* O; int ldc, act_lo, act_hi;
    __device__ __forceinline__ void operator()(const f32x4 (&acc)[2][2][4][2], const Unit& u, int wr, int wc, int fr, int fq) const {
        const int row0 = u.pm * BM + wr * 64 + fr, col0 = u.pn * BM + wc * 32 + 8 * fq;
        const bool act = u.pn >= act_lo && u.pn < act_hi;
#pragma unroll
        for (int ai = 0; ai < 2; ++ai) if (u.h != 2 - ai)
#pragma unroll
            for (int m = 0; m < 4; ++m) { bf16_t* rowp = O + (size_t)(row0 + ai * HALF + m * 16) * ldc + col0;
#pragma unroll
                for (int bj = 0; bj < 2; ++bj) { f32x4 v0 = acc[ai][bj][m][0], v1 = acc[ai][bj][m][1];
                    if (act) {
#pragma unroll
                        for (int j = 0; j < 4; ++j) { v0[j] = silu_f(v0[j]); v1[j] = silu_f(v1[j]); } }
                    u32x4 w; w.x = cvt_pk_bf16(v0[0], v0[1]); w.y = cvt_pk_bf16(v0[2], v0[3]); w.z = cvt_pk_bf16(v1[0], v1[1]); w.w = cvt_pk_bf16(v1[2], v1[3]);
                    *(u32x4*)(rowp + bj * HALF) = w; } }
    }
};
struct EpiStoreFp8 {
    static constexpr bool PERM = true;
    unsigned char* O;
    __device__ __forceinline__ void operator()(const f32x4 (&acc)[2][2][4][2], const Unit& u, int wr, int wc, int fr, int fq) const {
        const int row0 = u.pm * BM + wr * 64 + fr, col0 = u.pn * BM + wc * 32 + 8 * fq;
#pragma unroll
        for (int ai = 0; ai < 2; ++ai)
#pragma unroll
            for (int m = 0; m < 4; ++m) { unsigned char* rowp = O + (size_t)(row0 + ai * HALF + m * 16) * Y_LD;
#pragma unroll
                for (int bj = 0; bj < 2; ++bj) { const f32x4 v0 = acc[ai][bj][m][0], v1 = acc[ai][bj][m][1];
                    float am = fmaxf(fmaxf(fmaxf(fabsf(v0[0]), fabsf(v0[1])), fmaxf(fabsf(v0[2]), fabsf(v0[3]))), fmaxf(fmaxf(fabsf(v1[0]), fabsf(v1[1])), fmaxf(fabsf(v1[2]), fabsf(v1[3]))));
                    am = xrow_max(am);
                    const float inv = am > 0.f ? Y_QMAX * __builtin_amdgcn_rcpf(am) : 0.f;
                    int w0 = __builtin_amdgcn_cvt_pk_fp8_f32(v0[0] * inv, v0[1] * inv, 0, false); w0 = __builtin_amdgcn_cvt_pk_fp8_f32(v0[2] * inv, v0[3] * inv, w0, true);
                    int w1 = __builtin_amdgcn_cvt_pk_fp8_f32(v1[0] * inv, v1[1] * inv, 0, false); w1 = __builtin_amdgcn_cvt_pk_fp8_f32(v1[2] * inv, v1[3] * inv, w1, true);
                    *(u32x2*)(rowp + col0 + bj * HALF) = (u32x2){(unsigned)w0, (unsigned)w1};
                    if (fq == 0) *(float*)(rowp + Y_SC + 4 * ((col0 + bj * HALF) >> 5)) = am * (1.0f / Y_QMAX); } }
    }
};
struct EpiResidual {
    static constexpr bool PERM = false;
    const float* X; bf16_t* O; const float* gate;
    __device__ __forceinline__ void operator()(const f32x4 (&acc)[2][2][4][2], const Unit& u, int wr, int wc, int fr, int fq) const {
        const int row0 = u.pm * BM + wr * 64 + fr, col0 = u.pn * BM + wc * 32 + 4 * fq;
        const float* gp = gate + (size_t)((u.pm * BM) / SEQ) * 6144 + col0;
        f32x4 gv[2][2];
#pragma unroll
        for (int bj = 0; bj < 2; ++bj)
#pragma unroll
            for (int n = 0; n < 2; ++n) gv[bj][n] = *(const f32x4*)(gp + bj * HALF + n * 16);
#pragma unroll
        for (int ai = 0; ai < 2; ++ai)
#pragma unroll
            for (int m = 0; m < 4; ++m) { const size_t off = (size_t)(row0 + ai * HALF + m * 16) * DM + col0, offb = (size_t)(row0 + ai * HALF + m * 16) * XB_LD + col0;
#pragma unroll
                for (int bj = 0; bj < 2; ++bj)
#pragma unroll
                    for (int n = 0; n < 2; ++n) { const f32x4 xv = *(const f32x4*)(X + off + bj * HALF + n * 16); const f32x4 r = xv + gv[bj][n] * acc[ai][bj][m][n];
                                                  u32x2 w; w.x = cvt_pk_bf16(r[0], r[1]); w.y = cvt_pk_bf16(r[2], r[3]); *(u32x2*)(O + offb + bj * HALF + n * 16) = w; }
                if (m == 3) asm volatile("" ::: "memory"); }
    }
};
struct EpiSwiglu {
    static constexpr bool PERM = true;
    bf16_t* HB;
    __device__ __forceinline__ void operator()(const f32x4 (&acc)[2][2][4][2], const Unit& u, int wr, int wc, int fr, int fq) const {
        const int row0 = u.pm * BM + wr * 64 + fr, col0 = u.pn * 128 + wc * 32 + 8 * fq;
#pragma unroll
        for (int ai = 0; ai < 2; ++ai)
#pragma unroll
            for (int m = 0; m < 4; ++m) { bf16_t* rowp = HB + (size_t)(row0 + ai * HALF + m * 16) * DEXP + col0;
                float h[8];
#pragma unroll
                for (int n = 0; n < 2; ++n)
#pragma unroll
                    for (int j = 0; j < 4; ++j) { const float gv = acc[ai][0][m][n][j], uv = acc[ai][1][m][n][j]; h[n * 4 + j] = gv * __builtin_amdgcn_rcpf(1.0f + __expf(-gv)) * uv; }
                u32x4 w; w.x = cvt_pk_bf16(h[0], h[1]); w.y = cvt_pk_bf16(h[2], h[3]); w.z = cvt_pk_bf16(h[4], h[5]); w.w = cvt_pk_bf16(h[6], h[7]);
                *(u32x4*)rowp = w; }
    }
};
struct EpiGateY {
    static constexpr bool PERM = true;
    bf16_t* Y; const float* sgate;
    __device__ __forceinline__ void operator()(const f32x4 (&acc)[2][2][4][2], const Unit& u, int wr, int wc, int fr, int fq) const {
        const int row0 = u.pm * BM + wr * 64 + fr, col0 = u.pn * BM + wc * 32 + 8 * fq;
#pragma unroll
        for (int ai = 0; ai < 2; ++ai)
#pragma unroll
            for (int m = 0; m < 4; ++m) { const int row = row0 + ai * HALF + m * 16; const float gv = sgate[row]; bf16_t* rowp = Y + (size_t)row * 512 + col0;
#pragma unroll
                for (int bj = 0; bj < 2; ++bj) { const f32x4 v0 = acc[ai][bj][m][0] * gv, v1 = acc[ai][bj][m][1] * gv;
                    u32x4 w; w.x = cvt_pk_bf16(v0[0], v0[1]); w.y = cvt_pk_bf16(v0[2], v0[3]); w.z = cvt_pk_bf16(v1[0], v1[1]); w.w = cvt_pk_bf16(v1[2], v1[3]);
                    *(u32x4*)(rowp + bj * HALF) = w; } }
    }
};
}

__device__ __forceinline__ void p0_mod_partials(LAS float* scs  , const float* __restrict__ c, const float* __restrict__ ada_w, float* __restrict__ modp, int gwave, int nwaves, int tid) {
    const int lane = tid & 63;
    for (int i = tid; i < 4096; i += NTHREADS) scs[i] = silu_f(c[i]);
    __syncthreads();
    for (int task = gwave; task < 768; task += nwaves) {
        const int ks = task & 7, cg = task >> 3, col = cg * 64 + lane;
        float a0 = 0.f, a1 = 0.f, a2 = 0.f, a3 = 0.f;
        for (int k0 = ks * 128; k0 < ks * 128 + 128; k0 += 16) {
            float w[16];
#pragma unroll
            for (int u = 0; u < 16; ++u) w[u] = ada_w[(size_t)(k0 + u) * 6144 + col];
#pragma unroll
            for (int u = 0; u < 16; ++u) { a0 += scs[k0 + u] * w[u]; a1 += scs[1024 + k0 + u] * w[u]; a2 += scs[2048 + k0 + u] * w[u]; a3 += scs[3072 + k0 + u] * w[u]; }
        }
        modp[(size_t)(ks * 4 + 0) * 6144 + col] = a0; modp[(size_t)(ks * 4 + 1) * 6144 + col] = a1;
        modp[(size_t)(ks * 4 + 2) * 6144 + col] = a2; modp[(size_t)(ks * 4 + 3) * 6144 + col] = a3;
    }
    __syncthreads();
}

template <class F>
__device__ __forceinline__ void xpose_tile(LAS float* tile, const F& f, bf16_t* dst, size_t ldd, int n0, int k0, int tid) {
    { const int nn = tid & 63, kk0 = tid >> 6;
#pragma unroll
      for (int i = 0; i < 8; ++i) { const int k = kk0 + 8 * i; tile[k * 65 + nn] = f(k0 + k, n0 + nn); } }
    __syncthreads();
    { const int kk = tid & 63, nn0 = tid >> 6;
#pragma unroll
      for (int i = 0; i < 8; ++i) { const int n = nn0 + 8 * i; dst[(size_t)(n0 + n) * ldd + k0 + kk] = f2bf(tile[kk * 65 + n]); } }
    __syncthreads();
}

struct FetchWin {
    const float* w_in;
    __device__ __forceinline__ float operator()(int k, int n) const {
        int src;
        if (n < PC_QLAT) src = n;
        else if (n < PC_B) src = n - PC_CKV + WC_CKV;
        else if (n < PC_A) src = n - PC_B + WC_B;
        else if (n < PC_WIX) src = n - PC_A + WC_A;
        else if (n < PC_END) src = n - PC_WIX + WC_WIX;
        else return 0.f;
        return w_in[(size_t)k * DIN + src];
    }
};
struct FetchPlain { const float* w; int ld; __device__ __forceinline__ float operator()(int k, int n) const { return w[(size_t)k * ld + n]; } };

constexpr int AB_S = 272, AB_IMG = 64 * AB_S;
__device__ __forceinline__ void absorb_mma(LAS unsigned char* sm, f32x4 (&acc)[2], int wave, int lane) {
    const int m = lane & 15, g = lane >> 4, mt = wave >> 1, nt0 = (wave & 1) * 2;
    acc[0] = (f32x4){0.f, 0.f, 0.f, 0.f}; acc[1] = (f32x4){0.f, 0.f, 0.f, 0.f};
#pragma unroll
    for (int ks = 0; ks < 4; ++ks) {
        const bf16x8 ahi = *(const LAS bf16x8*)(sm + (16 * mt + m) * AB_S + (32 * ks + 8 * g) * 2), alo = *(const LAS bf16x8*)(sm + AB_IMG + (16 * mt + m) * AB_S + (32 * ks + 8 * g) * 2);
#pragma unroll
        for (int t = 0; t < 2; ++t) {
            const bf16x8 bhi = *(const LAS bf16x8*)(sm + 2 * AB_IMG + (16 * (nt0 + t) + m) * AB_S + (32 * ks + 8 * g) * 2), blo = *(const LAS bf16x8*)(sm + 3 * AB_IMG + (16 * (nt0 + t) + m) * AB_S + (32 * ks + 8 * g) * 2);
            acc[t] = __builtin_amdgcn_mfma_f32_16x16x32_bf16(ahi, bhi, acc[t], 0, 0, 0);
            acc[t] = __builtin_amdgcn_mfma_f32_16x16x32_bf16(ahi, blo, acc[t], 0, 0, 0);
            acc[t] = __builtin_amdgcn_mfma_f32_16x16x32_bf16(alo, bhi, acc[t], 0, 0, 0);
        }
    }
}
__device__ __forceinline__ void absorb_put4(LAS unsigned char* img_hi, int row, int col, f32x4 v) {
    const unsigned h0 = cvt_pk_bf16(v[0], v[1]), h1 = cvt_pk_bf16(v[2], v[3]);
    const unsigned l0 = cvt_pk_bf16(v[0] - bflo(h0), v[1] - bfhi(h0)), l1 = cvt_pk_bf16(v[2] - bflo(h1), v[3] - bfhi(h1));
    *(LAS u32x2*)(img_hi + row * AB_S + col * 2) = (u32x2){h0, h1}; *(LAS u32x2*)(img_hi + AB_IMG + row * AB_S + col * 2) = (u32x2){l0, l1};
}
__device__ __forceinline__ void absorb_qlat_tile(LAS float* smf, const float* __restrict__ w_in, const float* __restrict__ w_uk, bf16_t* WinT, int item, int tid) {
    LAS unsigned char* sm = (LAS unsigned char*)smf;
    const int kt = item & 15, hr = item >> 4, h = hr >> 2, r0 = (hr & 3) * 64, k0 = kt * 64, wave = tid >> 6, lane = tid & 63;
    for (int i = tid; i < 64 * 32; i += NTHREADS) { const int r = i >> 5, d = (i & 31) * 4;
        absorb_put4(sm, r, d, *(const f32x4*)(w_uk + ((size_t)h * 256 + r0 + r) * 128 + d));
        absorb_put4(sm + 2 * AB_IMG, r, d, *(const f32x4*)(w_in + (size_t)(k0 + r) * DIN + WC_QSA + h * 128 + d)); }
    __syncthreads();
    f32x4 acc[2]; absorb_mma(sm, acc, wave, lane);
    const int m = lane & 15, g = lane >> 4, mt = wave >> 1, nt0 = (wave & 1) * 2;
#pragma unroll
    for (int t = 0; t < 2; ++t)
#pragma unroll
        for (int j = 0; j < 4; ++j) WinT[(size_t)(PC_QLAT + h * 256 + r0 + 16 * mt + 4 * g + j) * 1024 + k0 + 16 * (nt0 + t) + m] = f2bf(acc[t][j] + 0.f);
    __syncthreads();
}
__device__ __forceinline__ void absorb_uvo_tile(LAS float* smf, const float* __restrict__ w_out, const float* __restrict__ w_uv, bf16_t* WoutT, int item, int tid) {
    LAS unsigned char* sm = (LAS unsigned char*)smf;
    const int nt = item & 15, hr = item >> 4, h = hr >> 2, r0 = (hr & 3) * 64, n0 = nt * 64, wave = tid >> 6, lane = tid & 63;
    for (int i = tid; i < 64 * 32; i += NTHREADS) { const int r = i >> 5, d = (i & 31) * 4; absorb_put4(sm + 2 * AB_IMG, r, d, *(const f32x4*)(w_uv + ((size_t)h * 256 + r0 + r) * 128 + d)); }
    for (int i = tid; i < 128 * 16; i += NTHREADS) { const int d = i >> 4, n = (i & 15) * 4; const f32x4 v = *(const f32x4*)(w_out + (size_t)(512 + h * 128 + d) * 1024 + n0 + n);
#pragma unroll
        for (int j = 0; j < 4; ++j) { const bf16_t hi = f2bf(v[j]); *(LAS bf16_t*)(sm + (n + j) * AB_S + d * 2) = hi; *(LAS bf16_t*)(sm + AB_IMG + (n + j) * AB_S + d * 2) = f2bf(v[j] - bf2f(hi)); } }
    __syncthreads();
    f32x4 acc[2]; absorb_mma(sm, acc, wave, lane);
    const int m = lane & 15, g = lane >> 4, mt = wave >> 1, nt0 = (wave & 1) * 2;
#pragma unroll
    for (int t = 0; t < 2; ++t)
#pragma unroll
        for (int j = 0; j < 4; ++j) WoutT[(size_t)(n0 + 16 * mt + 4 * g + j) * KMIX + 512 + h * 256 + r0 + 16 * (nt0 + t) + m] = f2bf(acc[t][j] + 0.f);
    __syncthreads();
}

__device__ __forceinline__ void p0_weights(LAS float* sm, const float* w_in, const float* w_uk, const float* w_uv, const float* w_out, bf16_t* WinT, bf16_t* WoutT, int blk, int nblk, int tid) {
    for (int j = blk; j < 1344; j += nblk) {
        const int item = j < 256 ? 704 + j : (j < 512 ? 1088 + (j - 256) : (j < 1216 ? j - 512 : 960 + (j - 1216)));
        if (item < 704) { int nt = item >> 4; const int kt = item & 15; if (nt >= 32) nt += 16;
            FetchWin f{w_in}; xpose_tile(sm, f, WinT, 1024, nt * 64, kt * 64, tid); }
        else if (item < 960) absorb_qlat_tile(sm, w_in, w_uk, WinT, item - 704, tid);
        else if (item < 1088) { const int it = item - 960, nt = it >> 3, kt = it & 7; FetchPlain f{w_out, 1024}; xpose_tile(sm, f, WoutT, KMIX, nt * 64, kt * 64, tid); }
        else absorb_uvo_tile(sm, w_out, w_uv, WoutT, item - 1088, tid);
    }
}

__device__ __forceinline__ void xpose_tile_w(LAS unsigned char* sm, const float* __restrict__ src, size_t ld, bf16_t* __restrict__ dst, size_t ldd, int tid) {
    const int kq = (tid >> 5) * 4, c4 = (tid & 31) * 4;
    f32x4 r[4];
#pragma unroll
    for (int p = 0; p < 4; ++p) r[p] = *(const f32x4*)(src + (size_t)(kq + p) * ld + c4);
#pragma unroll
    for (int j = 0; j < 4; ++j) { u32x2 w; w.x = cvt_pk_bf16(r[0][j], r[1][j]); w.y = cvt_pk_bf16(r[2][j], r[3][j]); *(LAS u32x2*)(sm + (c4 + j) * 144 + kq * 2) = w; }
    __syncthreads();
    { const int n = tid >> 2, pc = (tid & 3) * 32;
      const u32x4 a = *(const LAS u32x4*)(sm + n * 144 + pc), b = *(const LAS u32x4*)(sm + n * 144 + pc + 16);
      bf16_t* o = dst + (size_t)n * ldd + (pc >> 1);
      *(u32x4*)o = a; *(u32x4*)(o + 8) = b; }
    __syncthreads();
}
__device__ __forceinline__ void xw_item(int item, const float* eg, const float* eu, const float* ed, const float* sg, const float* su, const float* sd, bf16_t* Wgu, bf16_t* Wdn,
                                        const float*& src, size_t& ld, bf16_t*& dst, size_t& ldd) {
    const int e = item / 96, it = item % 96;
    if (it < 64) { const int nt = it >> 4, kt = it & 15, pn = nt >> 1, bj = nt & 1;
        const float* base = bj ? (e < NEXP ? eu + (size_t)e * 1024 * 256 : su) : (e < NEXP ? eg + (size_t)e * 1024 * 256 : sg);
        src = base + (size_t)kt * 64 * 256 + pn * 128; ld = 256; dst = Wgu + (size_t)e * 512 * 1024 + (size_t)nt * 128 * 1024 + kt * 64; ldd = 1024; }
    else { const int i2 = it - 64, nt = i2 >> 2, kt = i2 & 3;
        const float* base = e < NEXP ? ed + (size_t)e * 256 * 1024 : sd;
        src = base + (size_t)kt * 64 * 1024 + nt * 128; ld = 1024; dst = Wdn + (size_t)e * 1024 * 256 + (size_t)nt * 128 * 256 + kt * 64; ldd = 256; }
}
__device__ __forceinline__ void p_expert_weights(LAS float* smf, const float* eg, const float* eu, const float* ed, const float* sg, const float* su, const float* sd, bf16_t* Wgu, bf16_t* Wdn, int blk, int nblk, int tid) {
    LAS unsigned char* sm = (LAS unsigned char*)smf;
    const int kq = (tid >> 5) * 4, c4 = (tid & 31) * 4;
    const int ntot = NEXP1 * 96;
    f32x4 rn[4];
    const float* src; size_t ld; bf16_t* dst; size_t ldd;
    int item = blk;
    if (item < ntot) { xw_item(item, eg, eu, ed, sg, su, sd, Wgu, Wdn, src, ld, dst, ldd);
#pragma unroll
        for (int p = 0; p < 4; ++p) rn[p] = *(const f32x4*)(src + (size_t)(kq + p) * ld + c4); }
    for (; item < ntot; item += nblk) {
        f32x4 r[4];
#pragma unroll
        for (int p = 0; p < 4; ++p) r[p] = rn[p];
        bf16_t* cdst = dst; const size_t cldd = ldd;
        if (item + nblk < ntot) { xw_item(item + nblk, eg, eu, ed, sg, su, sd, Wgu, Wdn, src, ld, dst, ldd);
#pragma unroll
            for (int p = 0; p < 4; ++p) rn[p] = *(const f32x4*)(src + (size_t)(kq + p) * ld + c4); }
#pragma unroll
        for (int j = 0; j < 4; ++j) { u32x2 w; w.x = cvt_pk_bf16(r[0][j], r[1][j]); w.y = cvt_pk_bf16(r[2][j], r[3][j]); *(LAS u32x2*)(sm + (c4 + j) * 144 + kq * 2) = w; }
        __syncthreads();
        { const int n = tid >> 2, pc = (tid & 3) * 32;
          const u32x4 a = *(const LAS u32x4*)(sm + n * 144 + pc), b = *(const LAS u32x4*)(sm + n * 144 + pc + 16);
          bf16_t* o = cdst + (size_t)n * cldd + (pc >> 1);
          *(u32x4*)o = a; *(u32x4*)(o + 8) = b; }
        __syncthreads();
    }
}

__device__ __forceinline__ void load_mod(LAS float* dst, const float* __restrict__ modp, const float* __restrict__ ada_b, int b, int off, int n, int tid) {
    for (int j = tid; j < n; j += NTHREADS) { float s = ada_b[off + j];
#pragma unroll
        for (int ks = 0; ks < 8; ++ks) s += modp[(size_t)(ks * 4 + b) * 6144 + off + j];
        dst[j] = s; }
}
__device__ __forceinline__ void p1_norm(LAS float* sm, const float* __restrict__ x, const float* __restrict__ gain, const float* __restrict__ modp, const float* __restrict__ ada_b, int modoff, bf16_t* __restrict__ H,
                                        int blk, int nblk, int tid) {
    const int wave = tid >> 6, lane = tid & 63;
    for (int tb = blk; tb < NTOK / 128; tb += nblk) {
        const int b = (tb * 128) / SEQ;
        __syncthreads();
        load_mod(sm, modp, ada_b, b, modoff, 2048, tid);
        __syncthreads();
        for (int r0 = wave * 16; r0 < wave * 16 + 16; r0 += 8) {
            f32x4 v[8][4];
#pragma unroll
            for (int rr = 0; rr < 8; ++rr) { const float* xp = x + ((size_t)tb * 128 + r0 + rr) * DM;
#pragma unroll
                for (int i = 0; i < 4; ++i) v[rr][i] = *(const f32x4*)(xp + i * 256 + lane * 4); }
#pragma unroll
            for (int rr = 0; rr < 8; ++rr) {
                const size_t row = (size_t)tb * 128 + r0 + rr;
                float ss = 0.f;
#pragma unroll
                for (int i = 0; i < 4; ++i) ss += v[rr][i][0] * v[rr][i][0] + v[rr][i][1] * v[rr][i][1] + v[rr][i][2] * v[rr][i][2] + v[rr][i][3] * v[rr][i][3];
                ss = wave_sum(ss);
                const float rstd = rsqrtf(ss * (1.0f / DM) + EPS);
#pragma unroll
                for (int i = 0; i < 4; ++i) { const int c0 = i * 256 + lane * 4; const f32x4 gv = *(const f32x4*)(gain + c0);
                    float o[4];
#pragma unroll
                    for (int j = 0; j < 4; ++j) o[j] = v[rr][i][j] * rstd * gv[j] * (1.0f + sm[1024 + c0 + j]) + sm[c0 + j];
                    u32x2 w; w.x = cvt_pk_bf16(o[0], o[1]); w.y = cvt_pk_bf16(o[2], o[3]);
                    *(u32x2*)(H + row * DM + c0) = w; }
            }
        }
    }
}
__device__ __forceinline__ void p_final_norm(const float* __restrict__ src, float* __restrict__ dst, const float* __restrict__ gain, int gwave, int nwaves, int lane) {
    for (int row = gwave; row < NTOK; row += nwaves) {
        const float* xp = src + (size_t)row * DM;
        f32x4 v[4]; float ss = 0.f;
#pragma unroll
        for (int i = 0; i < 4; ++i) { v[i] = *(const f32x4*)(xp + i * 256 + lane * 4); ss += v[i][0] * v[i][0] + v[i][1] * v[i][1] + v[i][2] * v[i][2] + v[i][3] * v[i][3]; }
        ss = wave_sum(ss);
        const float rstd = rsqrtf(ss * (1.0f / DM) + EPS);
#pragma unroll
        for (int i = 0; i < 4; ++i) { const int c0 = i * 256 + lane * 4; const f32x4 gv = *(const f32x4*)(gain + c0);
            *(f32x4*)(dst + (size_t)row * DM + c0) = v[i] * rstd * gv; }
    }
}

__device__ __forceinline__ void p3_token_prep(const bf16_t* __restrict__ P, const float* __restrict__ kvg, const float* __restrict__ lng, const float* __restrict__ lnb,
                                              bf16_t* __restrict__ CKV, bf16_t* __restrict__ KIX, float* __restrict__ WIX, int gwave, int nwaves, int lane) {
    const f32x4 kg = *(const f32x4*)(kvg + lane * 4);
    const float g1 = lng[lane], b1 = lnb[lane];
    for (int t0 = gwave * 4; t0 < NTOK; t0 += nwaves * 4) {
        u32x2 cw[4]; unsigned short kxr[4], wxr[4];
#pragma unroll
        for (int q = 0; q < 4; ++q) { const bf16_t* pr = P + (size_t)(t0 + q) * NP; cw[q] = *(const u32x2*)(pr + PC_CKV + lane * 4); kxr[q] = pr[PC_KIX + lane]; wxr[q] = pr[PC_WIX + (lane & 3)]; }
#pragma unroll
        for (int q = 0; q < 4; ++q) {
            const int t = t0 + q;
            float v0 = bflo(cw[q].x), v1 = bfhi(cw[q].x), v2 = bflo(cw[q].y), v3 = bfhi(cw[q].y);
            const float ss = wave_sum(v0 * v0 + v1 * v1 + v2 * v2 + v3 * v3);
            const float rs = rsqrtf(ss * (1.0f / 256.0f) + EPS);
            u32x2 ow; ow.x = cvt_pk_bf16(v0 * rs * kg[0], v1 * rs * kg[1]); ow.y = cvt_pk_bf16(v2 * rs * kg[2], v3 * rs * kg[3]);
            *(u32x2*)(CKV + (size_t)t * 256 + lane * 4) = ow;
            const float kx = bf2f(kxr[q]);
            const float mu = wave_sum(kx) * (1.0f / 64.0f);
            const float xc = kx - mu;
            const float var = wave_sum(xc * xc) * (1.0f / 64.0f);
            { const int bb = t / SEQ, kk = t % SEQ;
              KIX[((size_t)bb * (SEQ / 16) + (kk >> 4)) * 1024 + (lane >> 5) * 512 + ((((lane >> 3) & 3) * 16 + (kk & 15)) * 8) + (lane & 7)] = f2bf(xc * rsqrtf(var + EPS) * g1 + b1); }
            if (lane < 4) WIX[(size_t)t * 4 + lane] = bf2f(wxr[q]) * 0.0625f;
        }
    }
}

constexpr int DN_REC_BYTES = 56 * 1024;
constexpr int DH_QN = 0;
constexpr int DH_KN = DH_QN + 64 * 136 * 2;
constexpr int DH_VB = DH_KN + 64 * 136 * 2;
constexpr int DH_AS = DH_VB + 64 * 136 * 2;
constexpr int DH_SM = DH_AS + 64 * 64 * 4;
constexpr int DH_BYTES = DH_SM + 6 * 64 * 4;
static_assert(2 * DH_BYTES <= LDS_MAIN_BYTES, "DeltaNet intra LDS");

template <class Gt>
__device__ __forceinline__ void dn_write_frags(const Gt& get, int nfrag, int nks, bf16_t* dst, int ht) {
    for (int w = ht; w < nfrag * 64; w += 256) {
        const int f = w >> 6, l = w & 63, mt = f / nks, ks = f % nks, m = l & 15, g = l >> 4;
        const int r = 16 * mt + m, c0 = 32 * ks + 4 * g;
        u32x4 o;
        o.x = cvt_pk_bf16(get(r, c0 + 0), get(r, c0 + 1)); o.y = cvt_pk_bf16(get(r, c0 + 2), get(r, c0 + 3));
        o.z = cvt_pk_bf16(get(r, c0 + 16), get(r, c0 + 17)); o.w = cvt_pk_bf16(get(r, c0 + 18), get(r, c0 + 19));
        *(u32x4*)(dst + (size_t)w * 8) = o;
    }
}

__device__ __forceinline__ void p3_dn_pair(LAS unsigned char* lds0, const bf16_t* __restrict__ P, const float* __restrict__ conv_w, const float* __restrict__ a_log, const float* __restrict__ dt_bias,
                                           unsigned char* __restrict__ regA, unsigned char* __restrict__ regC, int pair, int tid, GBar& gb) {
    const int lane = tid & 63, wave = __builtin_amdgcn_readfirstlane(tid >> 6), half = wave >> 2, hw = wave & 3, ht = tid & 255;
    const int item = 2 * pair + half;
    LAS unsigned char* lds = lds0 + half * DH_BYTES;
    const int n = item & 127, bh = item >> 7, b = bh >> 2, h = bh & 3, cid = item;
    const int t0 = b * SEQ + n * CHUNK;
    LAS bf16_t* qn = (LAS bf16_t*)(lds + DH_QN); LAS bf16_t* kn = (LAS bf16_t*)(lds + DH_KN); LAS bf16_t* vb = (LAS bf16_t*)(lds + DH_VB);
    LAS float* As = (LAS float*)(lds + DH_AS);
    LAS float* gc = (LAS float*)(lds + DH_SM); LAS float* bet = gc + 64; LAS float* eg = gc + 128; LAS float* ek = gc + 192; LAS float* rs = gc + 256;
    {
        LAS unsigned char* rawl = lds + DH_AS;
        const int cg = ht & 15, rb = ht >> 4;
        u32x4 rv[5];
#define DN_FETCH(w_) do { _Pragma("unroll") for (int q = 0; q < 5; ++q) { const int pc = ht + 256 * q; const int r = pc >> 4, c16 = pc & 15; const int tt = n * CHUNK + r - 3; \
            rv[q] = (u32x4){0u, 0u, 0u, 0u}; if (pc < 67 * 16 && tt >= 0) rv[q] = *(const u32x4*)(P + (size_t)(b * SEQ + tt) * NP + (w_) * 512 + h * 128 + c16 * 8); } } while (0)
        DN_FETCH(0);
#pragma unroll 1
        for (int which = 0; which < 3; ++which) {
            const int pcol0 = which * 512 + h * 128;
#pragma unroll
            for (int q = 0; q < 5; ++q) { const int pc = ht + 256 * q; if (pc < 67 * 16) *(LAS u32x4*)(rawl + (pc >> 4) * 256 + (pc & 15) * 16) = rv[q]; }
            if (which < 2) DN_FETCH(which + 1);
            f32x4 wlo[4], whi[4];
#pragma unroll
            for (int j = 0; j < 4; ++j) { const float* wr_ = conv_w + (size_t)j * 1536 + pcol0 + cg * 8; wlo[j] = *(const f32x4*)wr_; whi[j] = *(const f32x4*)(wr_ + 4); }
            gbar_sync(gb, lane);
            u32x4 rw_[7];
#pragma unroll
            for (int q = 0; q < 7; ++q) rw_[q] = *(const LAS u32x4*)(rawl + (4 * rb + q) * 256 + cg * 16);
            float y[4][8]; float ss[4];
#pragma unroll
            for (int rr = 0; rr < 4; ++rr) {
#pragma unroll
                for (int c = 0; c < 8; ++c) y[rr][c] = 0.f;
#pragma unroll
                for (int j = 0; j < 4; ++j) { const u32x4 r = rw_[rr + j];
                    y[rr][0] += wlo[j][0] * bflo(r.x); y[rr][1] += wlo[j][1] * bfhi(r.x); y[rr][2] += wlo[j][2] * bflo(r.y); y[rr][3] += wlo[j][3] * bfhi(r.y);
                    y[rr][4] += whi[j][0] * bflo(r.z); y[rr][5] += whi[j][1] * bfhi(r.z); y[rr][6] += whi[j][2] * bflo(r.w); y[rr][7] += whi[j][3] * bfhi(r.w); }
                ss[rr] = 0.f;
#pragma unroll
                for (int c = 0; c < 8; ++c) { y[rr][c] = silu_f(y[rr][c]); ss[rr] += y[rr][c] * y[rr][c]; }
            }
            LAS bf16_t* dstb = (which == 0 ? qn : (which == 1 ? kn : vb));
#pragma unroll
            for (int rr = 0; rr < 4; ++rr) {
                float sc = 1.0f;
                if (which < 2) { float s = row16_sum(ss[rr]); sc = rsqrtf(s + EPS) * (which == 0 ? 0.08838834764831845f : 1.0f); }
                u32x4 o; o.x = cvt_pk_bf16(y[rr][0] * sc, y[rr][1] * sc); o.y = cvt_pk_bf16(y[rr][2] * sc, y[rr][3] * sc); o.z = cvt_pk_bf16(y[rr][4] * sc, y[rr][5] * sc); o.w = cvt_pk_bf16(y[rr][6] * sc, y[rr][7] * sc);
                *(LAS u32x4*)(dstb + (4 * rb + rr) * 136 + cg * 8) = o;
            }
            gbar_sync(gb, lane);
        }
#undef DN_FETCH
    }
    if (hw == 0) {
        const bf16_t* pr = P + (size_t)(t0 + lane) * NP;
        const float bb = sigmoid_f(bf2f(pr[PC_B + h]));
        const float xa = bf2f(pr[PC_A + h]) + dt_bias[h];
        const float sp = xa > 20.f ? xa : log1pf(__expf(xa));
        float gv = -__expf(a_log[h]) * sp;
        gv = wave_scan_incl_f(gv);
        const float glast = __int_as_float(__builtin_amdgcn_readlane(__float_as_int(gv), 63));
        gc[lane] = gv; bet[lane] = bb; eg[lane] = __expf(gv); ek[lane] = __expf(glast - gv); rs[lane] = bb; rs[64 + lane] = bb * __expf(gv);
        if (lane == 63) ((float*)(regA + A_GTOT))[cid] = __expf(gv);
    }
    gbar_sync(gb, lane);
    const int m = lane & 15, g = lane >> 4, mt = hw;
    f32x4 cqk[4];
    {
        bf16x8 ak[4], aq[4];
#pragma unroll
        for (int ks = 0; ks < 4; ++ks) { ak[ks] = *(const LAS bf16x8*)(kn + (16 * mt + m) * 136 + 32 * ks + 8 * g); aq[ks] = *(const LAS bf16x8*)(qn + (16 * mt + m) * 136 + 32 * ks + 8 * g); }
#pragma unroll
        for (int nt = 0; nt < 4; ++nt) {
            f32x4 ckk = (f32x4){0.f, 0.f, 0.f, 0.f}; cqk[nt] = (f32x4){0.f, 0.f, 0.f, 0.f};
            if (nt <= mt) {
#pragma unroll
                for (int ks = 0; ks < 4; ++ks) { const bf16x8 bk = *(const LAS bf16x8*)(kn + (16 * nt + m) * 136 + 32 * ks + 8 * g);
                    ckk = __builtin_amdgcn_mfma_f32_16x16x32_bf16(ak[ks], bk, ckk, 0, 0, 0);
                    cqk[nt] = __builtin_amdgcn_mfma_f32_16x16x32_bf16(aq[ks], bk, cqk[nt], 0, 0, 0); }
            }
            const int j = 16 * nt + m; const float gj = gc[j];
#pragma unroll
            for (int jj = 0; jj < 4; ++jj) { const int i = 16 * mt + 4 * g + jj; const float dec = __expf(gc[i] - gj);
                As[i * 64 + j] = (i > j) ? bet[i] * ckk[jj] * dec : 0.f;
                cqk[nt][jj] = (i >= j) ? cqk[nt][jj] * dec : 0.f; }
        }
    }
    gbar_sync(gb, lane);
    float xs[64];
    {
        const int col = (hw & 1) * 64 + lane;
        const LAS bf16_t* rp = (hw < 2 ? vb : kn) + col;
        const LAS float* sp = rs + (hw < 2 ? 0 : 64);
#pragma unroll
        for (int rb = 0; rb < 4; ++rb) {
            float acc[16];
#pragma unroll
            for (int ii = 0; ii < 16; ++ii) acc[ii] = bf2f(rp[(16 * rb + ii) * 136]) * sp[16 * rb + ii];
#pragma unroll
            for (int hf = 0; hf < 2; ++hf)
#pragma unroll
            for (int j4 = 0; j4 < 4 * rb; ++j4) {
                asm volatile("" ::: "memory");
                f32x4 av[8];
#pragma unroll
                for (int ii = 0; ii < 8; ++ii) av[ii] = *(const LAS f32x4*)(As + (16 * rb + 8 * hf + ii) * 64 + 4 * j4);
#pragma unroll
                for (int ii = 0; ii < 8; ++ii) acc[8 * hf + ii] -= av[ii][0] * xs[4 * j4] + av[ii][1] * xs[4 * j4 + 1] + av[ii][2] * xs[4 * j4 + 2] + av[ii][3] * xs[4 * j4 + 3];
            }
#pragma unroll
            for (int i4 = 0; i4 < 4; ++i4) {
                asm volatile("" ::: "memory");
                f32x4 dv[4][4];
#pragma unroll
                for (int q = 0; q < 4; ++q)
#pragma unroll
                    for (int j4 = 0; j4 <= i4; ++j4) dv[q][j4] = *(const LAS f32x4*)(As + (16 * rb + 4 * i4 + q) * 64 + 16 * rb + 4 * j4);
#pragma unroll
                for (int q = 0; q < 4; ++q) { const int ii = 4 * i4 + q; float s = acc[ii];
#pragma unroll
                    for (int jj = 0; jj < ii; ++jj) s -= dv[q][jj >> 2][jj & 3] * xs[16 * rb + jj];
                    asm volatile("" : "+v"(s));
                    xs[16 * rb + ii] = s; }
            }
        }
    }
    gbar_sync(gb, lane);
    LAS bf16_t* wsl = (LAS bf16_t*)(lds + DH_VB); LAS bf16_t* QKs = (LAS bf16_t*)(lds + DH_AS);
    if (hw < 2) {
        bf16_t* ut = (bf16_t*)(regA + A_UT) + ((size_t)cid * 128 + hw * 64 + lane) * 64;
#pragma unroll
        for (int i = 0; i < 64; i += 8) { u32x4 o; o.x = cvt_pk_bf16(xs[i], xs[i + 1]); o.y = cvt_pk_bf16(xs[i + 2], xs[i + 3]); o.z = cvt_pk_bf16(xs[i + 4], xs[i + 5]); o.w = cvt_pk_bf16(xs[i + 6], xs[i + 7]);
            *(u32x4*)(ut + i) = o; }
    } else {
        const int col = (hw & 1) * 64 + lane;
#pragma unroll
        for (int i = 0; i < 64; ++i) wsl[i * 136 + col] = f2bf(xs[i]);
    }
#pragma unroll
    for (int nt = 0; nt < 4; ++nt) { const int j = 16 * nt + m;
#pragma unroll
        for (int jj = 0; jj < 4; ++jj) QKs[(16 * mt + 4 * g + jj) * 72 + j] = f2bf(cqk[nt][jj]); }
    gbar_sync(gb, lane);
    {
        bf16_t* rec = (bf16_t*)(regC + (size_t)cid * DN_REC_BYTES);
        dn_write_frags([&](int r, int c) { return bf2f(wsl[r * 136 + c]); }, 16, 4, rec, ht);
        dn_write_frags([&](int r, int c) { return bf2f(qn[r * 136 + c]) * eg[r]; }, 16, 4, rec + 16 * 512, ht);
        dn_write_frags([&](int r, int c) { return bf2f(QKs[r * 72 + c]); }, 8, 2, rec + 32 * 512, ht);
        dn_write_frags([&](int r, int c) { return bf2f(kn[c * 136 + r]) * ek[c]; }, 16, 2, rec + 40 * 512, ht);
    }
    gbar_sync(gb, lane);
}

__device__ __forceinline__ void p4_dn_scan(LAS unsigned char* lds, unsigned char* __restrict__ regA, const unsigned char* __restrict__ regC, int bh, int tid) {
    const int lane = tid & 63, wave = __builtin_amdgcn_readfirstlane(tid >> 6), m = lane & 15, g = lane >> 4;
    LAS unsigned char* buf = lds;
    static_assert(2 * DN_REC_BYTES <= LDS_MAIN_BYTES, "scan LDS");
    f32x4 S[8];
#pragma unroll
    for (int i = 0; i < 8; ++i) S[i] = (f32x4){0.f, 0.f, 0.f, 0.f};
    const unsigned char* rec0 = regC + (size_t)bh * 128 * DN_REC_BYTES;
    bf16_t* ut0 = (bf16_t*)(regA + A_UT) + (size_t)bh * 128 * 128 * 64 + (size_t)(16 * wave + m) * 64 + 4 * g;
    const float* gtot = (const float*)(regA + A_GTOT) + bh * 128;
    const float gt_lo = gtot[lane], gt_hi = gtot[64 + lane];
#pragma unroll
    for (int i = 0; i < 7; ++i) { const int piece = wave * 7 + i;
        __builtin_amdgcn_global_load_lds((const unsigned*)(rec0 + (size_t)piece * 1024 + lane * 16), (LAS unsigned*)(buf + piece * 1024), 16, 0, 0); }
    u32x2 un[4];
#define SCAN_FETCH(n_) do { _Pragma("unroll") for (int mt = 0; mt < 4; ++mt) un[mt] = *(const u32x2*)(ut0 + (size_t)(n_) * 128 * 64 + 16 * mt); } while (0)
#define SCAN_LANDED(cnt) asm volatile("s_waitcnt vmcnt(" #cnt ")" : "+v"(un[0]), "+v"(un[1]), "+v"(un[2]), "+v"(un[3]) :: "memory")
    SCAN_FETCH(0);
    SCAN_LANDED(0);
    for (int n = 0; n < NCH; ++n) {
        __syncthreads();
        f32x4 u[4];
#pragma unroll
        for (int mt = 0; mt < 4; ++mt) u[mt] = (f32x4){bflo(un[mt].x), bfhi(un[mt].x), bflo(un[mt].y), bfhi(un[mt].y)};
        if (n + 1 < NCH) {
            const unsigned char* rn = rec0 + (size_t)(n + 1) * DN_REC_BYTES; LAS unsigned char* bn = buf + ((n + 1) & 1) * DN_REC_BYTES;
#pragma unroll
            for (int i = 0; i < 7; ++i) { const int piece = wave * 7 + i;
                __builtin_amdgcn_global_load_lds((const unsigned*)(rn + (size_t)piece * 1024 + lane * 16), (LAS unsigned*)(bn + piece * 1024), 16, 0, 0); }
            SCAN_FETCH(n + 1);
        }
        const LAS unsigned char* bc = buf + (n & 1) * DN_REC_BYTES;
        const float gt = __builtin_bit_cast(float, __builtin_amdgcn_readlane(__builtin_bit_cast(int, n < 64 ? gt_lo : gt_hi), n & 63));
        bf16x8 Sb[4];
#pragma unroll
        for (int ks = 0; ks < 4; ++ks) { u32x4 w; w.x = cvt_pk_bf16(S[2 * ks][0], S[2 * ks][1]); w.y = cvt_pk_bf16(S[2 * ks][2], S[2 * ks][3]); w.z = cvt_pk_bf16(S[2 * ks + 1][0], S[2 * ks + 1][1]); w.w = cvt_pk_bf16(S[2 * ks + 1][2], S[2 * ks + 1][3]);
            Sb[ks] = __builtin_bit_cast(bf16x8, w); }
        f32x4 vn[4];
#pragma unroll
        for (int mt = 0; mt < 4; ++mt) { f32x4 acc = (f32x4){0.f, 0.f, 0.f, 0.f};
#pragma unroll
            for (int ks = 0; ks < 4; ++ks) { const bf16x8 af = *(const LAS bf16x8*)(bc + (mt * 4 + ks) * 1024 + lane * 16); acc = __builtin_amdgcn_mfma_f32_16x16x32_bf16(af, Sb[ks], acc, 0, 0, 0); }
            vn[mt] = u[mt] - acc; }
        bf16x8 Vb[2];
#pragma unroll
        for (int ks = 0; ks < 2; ++ks) { u32x4 w; w.x = cvt_pk_bf16(vn[2 * ks][0], vn[2 * ks][1]); w.y = cvt_pk_bf16(vn[2 * ks][2], vn[2 * ks][3]); w.z = cvt_pk_bf16(vn[2 * ks + 1][0], vn[2 * ks + 1][1]); w.w = cvt_pk_bf16(vn[2 * ks + 1][2], vn[2 * ks + 1][3]);
            Vb[ks] = __builtin_bit_cast(bf16x8, w); }
#pragma unroll
        for (int mt = 0; mt < 4; ++mt) { f32x4 acc = (f32x4){0.f, 0.f, 0.f, 0.f};
#pragma unroll
            for (int ks = 0; ks < 4; ++ks) { const bf16x8 af = *(const LAS bf16x8*)(bc + (16 + mt * 4 + ks) * 1024 + lane * 16); acc = __builtin_amdgcn_mfma_f32_16x16x32_bf16(af, Sb[ks], acc, 0, 0, 0); }
#pragma unroll
            for (int ks = 0; ks < 2; ++ks) { const bf16x8 af = *(const LAS bf16x8*)(bc + (32 + mt * 2 + ks) * 1024 + lane * 16); acc = __builtin_amdgcn_mfma_f32_16x16x32_bf16(af, Vb[ks], acc, 0, 0, 0); }
            const float o0 = acc[0], o1 = acc[1], o2 = acc[2], o3 = acc[3];
            u32x2 ow; ow.x = cvt_pk_bf16_mfma(o0, o1); ow.y = cvt_pk_bf16(o2, o3);
            *(u32x2*)(ut0 + (size_t)n * 128 * 64 + 16 * mt) = ow; }
#pragma unroll
        for (int mt = 0; mt < 8; ++mt) { f32x4 acc = S[mt] * gt;
#pragma unroll
            for (int ks = 0; ks < 2; ++ks) { const bf16x8 af = *(const LAS bf16x8*)(bc + (40 + mt * 2 + ks) * 1024 + lane * 16); acc = __builtin_amdgcn_mfma_f32_16x16x32_bf16(af, Vb[ks], acc, 0, 0, 0); }
            S[mt] = acc; }
        SCAN_LANDED(4);
    }
#undef SCAN_FETCH
#undef SCAN_LANDED
    asm volatile("s_waitcnt vmcnt(0)" ::: "memory");
    __syncthreads();
}

__device__ __forceinline__ void p4_dn_scan_fin(LAS unsigned char* lds, bf16_t* __restrict__ P, const float* __restrict__ dn_g, unsigned char* __restrict__ regA, const unsigned char* __restrict__ regC, int bh, int tid) {
    const int lane = tid & 63, wave = __builtin_amdgcn_readfirstlane(tid >> 6), m = lane & 15, g = lane >> 4;
    LAS unsigned char* buf = lds;
    constexpr int OT_LD = 66, OT_SZ = 128 * OT_LD;
    LAS bf16_t* otb = (LAS bf16_t*)(lds + 2 * DN_REC_BYTES);
    static_assert(2 * DN_REC_BYTES + 2 * OT_SZ * 2 <= LDS_MAIN_BYTES, "scan LDS");
    const int fpos = tid >> 3, fd0 = (tid & 7) * 16;
    float gl[16];
#pragma unroll
    for (int j = 0; j < 16; ++j) gl[j] = dn_g[fd0 + j];
    bf16_t* frow = P + (size_t)((bh >> 2) * SEQ + fpos) * NP + (bh & 3) * 128 + fd0;
    u32x4 zn0 = (u32x4){0u, 0u, 0u, 0u}, zn1 = zn0;
    f32x4 S[8];
#pragma unroll
    for (int i = 0; i < 8; ++i) S[i] = (f32x4){0.f, 0.f, 0.f, 0.f};
    const unsigned char* rec0 = regC + (size_t)bh * 128 * DN_REC_BYTES;
    bf16_t* ut0 = (bf16_t*)(regA + A_UT) + (size_t)bh * 128 * 128 * 64 + (size_t)(16 * wave + m) * 64 + 4 * g;
    const float* gtot = (const float*)(regA + A_GTOT) + bh * 128;
    const float gt_lo = gtot[lane], gt_hi = gtot[64 + lane];
#pragma unroll
    for (int i = 0; i < 7; ++i) { const int piece = wave * 7 + i;
        __builtin_amdgcn_global_load_lds((const unsigned*)(rec0 + (size_t)piece * 1024 + lane * 16), (LAS unsigned*)(buf + piece * 1024), 16, 0, 0); }
    u32x2 un[4];
#define SCAN_FETCH(n_) do { _Pragma("unroll") for (int mt = 0; mt < 4; ++mt) un[mt] = *(const u32x2*)(ut0 + (size_t)(n_) * 128 * 64 + 16 * mt); } while (0)
#define SCAN_LANDED(cnt) asm volatile("s_waitcnt vmcnt(" #cnt ")" : "+v"(un[0]), "+v"(un[1]), "+v"(un[2]), "+v"(un[3]) :: "memory")
    SCAN_FETCH(0);
    SCAN_LANDED(0);
#define SCAN_FINISH(nf_, z0_, z1_) do { const LAS bf16_t* ot_ = otb + ((nf_) & 1) * OT_SZ; float v_[16]; float ss_ = 0.f; \
        _Pragma("unroll") for (int j = 0; j < 16; ++j) { v_[j] = bf2f(ot_[(fd0 + j) * OT_LD + fpos]); ss_ += v_[j] * v_[j]; } \
        ss_ = oct_sum(ss_); const float rstd_ = rsqrtf(ss_ * (1.0f / 128.0f) + EPS); \
        const float zf_[16] = {bflo(z0_.x), bfhi(z0_.x), bflo(z0_.y), bfhi(z0_.y), bflo(z0_.z), bfhi(z0_.z), bflo(z0_.w), bfhi(z0_.w), bflo(z1_.x), bfhi(z1_.x), bflo(z1_.y), bfhi(z1_.y), bflo(z1_.z), bfhi(z1_.z), bflo(z1_.w), bfhi(z1_.w)}; \
        float r_[16]; _Pragma("unroll") for (int j = 0; j < 16; ++j) r_[j] = v_[j] * rstd_ * gl[j] * zf_[j]; \
        u32x4 w0_, w1_; w0_.x = cvt_pk_bf16(r_[0], r_[1]); w0_.y = cvt_pk_bf16(r_[2], r_[3]); w0_.z = cvt_pk_bf16(r_[4], r_[5]); w0_.w = cvt_pk_bf16(r_[6], r_[7]); \
        w1_.x = cvt_pk_bf16(r_[8], r_[9]); w1_.y = cvt_pk_bf16(r_[10], r_[11]); w1_.z = cvt_pk_bf16(r_[12], r_[13]); w1_.w = cvt_pk_bf16(r_[14], r_[15]); \
        bf16_t* o_ = frow + (size_t)(nf_) * CHUNK * NP; *(u32x4*)o_ = w0_; *(u32x4*)(o_ + 8) = w1_; } while (0)
#define SCAN_FIN1(nf_) const LAS bf16_t* ot_ = otb + ((nf_) & 1) * OT_SZ; float fv_[16]; float fss_ = 0.f; \
        _Pragma("unroll") for (int j = 0; j < 16; ++j) { fv_[j] = bf2f(ot_[(fd0 + j) * OT_LD + fpos]); fss_ += fv_[j] * fv_[j]; } \
        fss_ = oct_sum(fss_); const float frs_ = rsqrtf(fss_ * (1.0f / 128.0f) + EPS); u32x4 fw0_, fw1_
#define SCAN_FIN2(z0_) do { const float zf_[8] = {bflo(z0_.x), bfhi(z0_.x), bflo(z0_.y), bfhi(z0_.y), bflo(z0_.z), bfhi(z0_.z), bflo(z0_.w), bfhi(z0_.w)}; float r_[8]; \
        _Pragma("unroll") for (int j = 0; j < 8; ++j) r_[j] = fv_[j] * frs_ * gl[j] * zf_[j]; \
        fw0_.x = cvt_pk_bf16(r_[0], r_[1]); fw0_.y = cvt_pk_bf16(r_[2], r_[3]); fw0_.z = cvt_pk_bf16(r_[4], r_[5]); fw0_.w = cvt_pk_bf16(r_[6], r_[7]); } while (0)
#define SCAN_FIN3(nf_, z1_) do { const float zf_[8] = {bflo(z1_.x), bfhi(z1_.x), bflo(z1_.y), bfhi(z1_.y), bflo(z1_.z), bfhi(z1_.z), bflo(z1_.w), bfhi(z1_.w)}; float r_[8]; \
        _Pragma("unroll") for (int j = 0; j < 8; ++j) r_[j] = fv_[8 + j] * frs_ * gl[8 + j] * zf_[j]; \
        fw1_.x = cvt_pk_bf16(r_[0], r_[1]); fw1_.y = cvt_pk_bf16(r_[2], r_[3]); fw1_.z = cvt_pk_bf16(r_[4], r_[5]); fw1_.w = cvt_pk_bf16(r_[6], r_[7]); \
        bf16_t* o_ = frow + (size_t)(nf_) * CHUNK * NP; *(u32x4*)o_ = fw0_; *(u32x4*)(o_ + 8) = fw1_; } while (0)
    for (int n = 0; n < NCH; ++n) {
        __syncthreads();
        const u32x4 zc0 = zn0, zc1 = zn1;
        f32x4 u[4];
#pragma unroll
        for (int mt = 0; mt < 4; ++mt) u[mt] = (f32x4){bflo(un[mt].x), bfhi(un[mt].x), bflo(un[mt].y), bfhi(un[mt].y)};
        if (n + 1 < NCH) {
            const unsigned char* rn = rec0 + (size_t)(n + 1) * DN_REC_BYTES; LAS unsigned char* bn = buf + ((n + 1) & 1) * DN_REC_BYTES;
#pragma unroll
            for (int i = 0; i < 7; ++i) { const int piece = wave * 7 + i;
                __builtin_amdgcn_global_load_lds((const unsigned*)(rn + (size_t)piece * 1024 + lane * 16), (LAS unsigned*)(bn + piece * 1024), 16, 0, 0); }
            SCAN_FETCH(n + 1);
        }
        { const bf16_t* zr = frow + (size_t)n * CHUNK * NP + PC_Z; zn0 = *(const u32x4*)zr; zn1 = *(const u32x4*)(zr + 8); }
        asm volatile("" ::: "memory");
        const int nf = n > 0 ? n - 1 : 0;
        SCAN_FIN1(nf);
        const LAS unsigned char* bc = buf + (n & 1) * DN_REC_BYTES;
        const float gt = __builtin_bit_cast(float, __builtin_amdgcn_readlane(__builtin_bit_cast(int, n < 64 ? gt_lo : gt_hi), n & 63));
        bf16x8 Sb[4];
#pragma unroll
        for (int ks = 0; ks < 4; ++ks) { u32x4 w; w.x = cvt_pk_bf16(S[2 * ks][0], S[2 * ks][1]); w.y = cvt_pk_bf16(S[2 * ks][2], S[2 * ks][3]); w.z = cvt_pk_bf16(S[2 * ks + 1][0], S[2 * ks + 1][1]); w.w = cvt_pk_bf16(S[2 * ks + 1][2], S[2 * ks + 1][3]);
            Sb[ks] = __builtin_bit_cast(bf16x8, w); }
        f32x4 vn[4];
#pragma unroll
        for (int mt = 0; mt < 4; ++mt) { f32x4 acc = (f32x4){0.f, 0.f, 0.f, 0.f};
#pragma unroll
            for (int ks = 0; ks < 4; ++ks) { const bf16x8 af = *(const LAS bf16x8*)(bc + (mt * 4 + ks) * 1024 + lane * 16); acc = __builtin_amdgcn_mfma_f32_16x16x32_bf16(af, Sb[ks], acc, 0, 0, 0); }
            vn[mt] = u[mt] - acc; }
        SCAN_FIN2(zc0);
        bf16x8 Vb[2];
#pragma unroll
        for (int ks = 0; ks < 2; ++ks) { u32x4 w; w.x = cvt_pk_bf16(vn[2 * ks][0], vn[2 * ks][1]); w.y = cvt_pk_bf16(vn[2 * ks][2], vn[2 * ks][3]); w.z = cvt_pk_bf16(vn[2 * ks + 1][0], vn[2 * ks + 1][1]); w.w = cvt_pk_bf16(vn[2 * ks + 1][2], vn[2 * ks + 1][3]);
            Vb[ks] = __builtin_bit_cast(bf16x8, w); }
#pragma unroll
        for (int mt = 0; mt < 4; ++mt) { f32x4 acc = (f32x4){0.f, 0.f, 0.f, 0.f};
#pragma unroll
            for (int ks = 0; ks < 4; ++ks) { const bf16x8 af = *(const LAS bf16x8*)(bc + (16 + mt * 4 + ks) * 1024 + lane * 16); acc = __builtin_amdgcn_mfma_f32_16x16x32_bf16(af, Sb[ks], acc, 0, 0, 0); }
#pragma unroll
            for (int ks = 0; ks < 2; ++ks) { const bf16x8 af = *(const LAS bf16x8*)(bc + (32 + mt * 2 + ks) * 1024 + lane * 16); acc = __builtin_amdgcn_mfma_f32_16x16x32_bf16(af, Vb[ks], acc, 0, 0, 0); }
            const float o0 = acc[0], o1 = acc[1], o2 = acc[2], o3 = acc[3];
            u32x2 ow; ow.x = cvt_pk_bf16_mfma(o0, o1); ow.y = cvt_pk_bf16(o2, o3);
            { LAS unsigned* od = (LAS unsigned*)(otb + (n & 1) * OT_SZ + (16 * wave + m) * OT_LD + 16 * mt + 4 * g); od[0] = ow.x; od[1] = ow.y; } }
        SCAN_FIN3(nf, zc1);
#pragma unroll
        for (int mt = 0; mt < 8; ++mt) { f32x4 acc = S[mt] * gt;
#pragma unroll
            for (int ks = 0; ks < 2; ++ks) { const bf16x8 af = *(const LAS bf16x8*)(bc + (40 + mt * 2 + ks) * 1024 + lane * 16); acc = __builtin_amdgcn_mfma_f32_16x16x32_bf16(af, Vb[ks], acc, 0, 0, 0); }
            S[mt] = acc; }
        SCAN_LANDED(2);
    }
#undef SCAN_FETCH
#undef SCAN_LANDED
    asm volatile("s_waitcnt vmcnt(0)" ::: "memory");
    __syncthreads();
    SCAN_FINISH(NCH - 1, zn0, zn1);
#undef SCAN_FINISH
#undef SCAN_FIN1
#undef SCAN_FIN2
#undef SCAN_FIN3
    asm volatile("s_waitcnt vmcnt(0)" ::: "memory");
    __syncthreads();
}

__device__ __forceinline__ void p5_dn_finish(LAS unsigned char* lds, bf16_t* __restrict__ P, const float* __restrict__ dn_g, const unsigned char* __restrict__ regA, int blk, int nblk, int tid) {
    LAS float* ot = (LAS float*)lds;
    const int dvr = tid >> 2, p0 = (tid & 3) * 16;
    const int pos = tid >> 3, d0 = (tid & 7) * 16;
    float gl[16];
#pragma unroll
    for (int j = 0; j < 16; ++j) gl[j] = dn_g[d0 + j];
    u32x4 ra = (u32x4){0u, 0u, 0u, 0u}, rc = ra;
    u32x4 zn0 = ra, zn1 = ra;
#define P5_ZROW(cid_) (P + (size_t)((((cid_) >> 7) >> 2) * SEQ + ((cid_) & 127) * CHUNK + pos) * NP + PC_Z + (((cid_) >> 7) & 3) * 128 + d0)
    if (blk < 2048) { const bf16_t* src = (const bf16_t*)(regA + A_UT) + (size_t)blk * 128 * 64; ra = *(const u32x4*)(src + dvr * 64 + p0); rc = *(const u32x4*)(src + dvr * 64 + p0 + 8);
                      const bf16_t* zr = P5_ZROW(blk); zn0 = *(const u32x4*)zr; zn1 = *(const u32x4*)(zr + 8); }
    for (int cid = blk; cid < 2048; cid += nblk) {
        const int n = cid & 127, bh = cid >> 7, b = bh >> 2, h = bh & 3, tok0 = b * SEQ + n * CHUNK;
        bf16_t* row = P + (size_t)(tok0 + pos) * NP;
        const u32x4 z0 = zn0, z1 = zn1;
        __syncthreads();
        { LAS float* o = ot + dvr * 65 + p0;
          o[0] = bflo(ra.x); o[1] = bfhi(ra.x); o[2] = bflo(ra.y); o[3] = bfhi(ra.y); o[4] = bflo(ra.z); o[5] = bfhi(ra.z); o[6] = bflo(ra.w); o[7] = bfhi(ra.w);
          o[8] = bflo(rc.x); o[9] = bfhi(rc.x); o[10] = bflo(rc.y); o[11] = bfhi(rc.y); o[12] = bflo(rc.z); o[13] = bfhi(rc.z); o[14] = bflo(rc.w); o[15] = bfhi(rc.w); }
        if (cid + nblk < 2048) { const bf16_t* src = (const bf16_t*)(regA + A_UT) + (size_t)(cid + nblk) * 128 * 64; ra = *(const u32x4*)(src + dvr * 64 + p0); rc = *(const u32x4*)(src + dvr * 64 + p0 + 8);
                                 const bf16_t* zr = P5_ZROW(cid + nblk); zn0 = *(const u32x4*)zr; zn1 = *(const u32x4*)(zr + 8); }
        __syncthreads();
        float v[16]; float ss = 0.f;
#pragma unroll
        for (int j = 0; j < 16; ++j) { v[j] = ot[(d0 + j) * 65 + pos]; ss += v[j] * v[j]; }
        ss = oct_sum(ss);
        const float rstd = rsqrtf(ss * (1.0f / 128.0f) + EPS);
        const float zf[16] = {bflo(z0.x), bfhi(z0.x), bflo(z0.y), bfhi(z0.y), bflo(z0.z), bfhi(z0.z), bflo(z0.w), bfhi(z0.w), bflo(z1.x), bfhi(z1.x), bflo(z1.y), bfhi(z1.y), bflo(z1.z), bfhi(z1.z), bflo(z1.w), bfhi(z1.w)};
        float r[16];
#pragma unroll
        for (int j = 0; j < 16; ++j) r[j] = v[j] * rstd * gl[j] * silu_f(zf[j]);
        u32x4 w0, w1;
        w0.x = cvt_pk_bf16(r[0], r[1]); w0.y = cvt_pk_bf16(r[2], r[3]); w0.z = cvt_pk_bf16(r[4], r[5]); w0.w = cvt_pk_bf16(r[6], r[7]);
        w1.x = cvt_pk_bf16(r[8], r[9]); w1.y = cvt_pk_bf16(r[10], r[11]); w1.z = cvt_pk_bf16(r[12], r[13]); w1.w = cvt_pk_bf16(r[14], r[15]);
        *(u32x4*)(row + h * 128 + d0) = w0; *(u32x4*)(row + h * 128 + d0 + 8) = w1;
    }
#undef P5_ZROW
    __syncthreads();
}

constexpr int AT_SC = 0;
constexpr int AT_RS = 8192 * 2 + 32;
constexpr int AT_HIST = 4 * AT_RS;
constexpr unsigned AT_WIN = 510u;
constexpr int AT_GRP = AT_HIST + 4 * 2048;
constexpr int AT_KV = 0;
constexpr int AT_KV_WAVE = 32 * 544;
static_assert(2 * AT_GRP <= LDS_MAIN_BYTES && 4 * AT_KV_WAVE <= AT_GRP, "attention LDS");
constexpr float SM_SCALE = 0.08838834764831845f;

__device__ __forceinline__ unsigned score_key(float s) { const unsigned u = __float_as_uint(s); return (u ^ ((unsigned)((int)u >> 31) | 0x80000000u)) >> 16; }
__device__ __forceinline__ float relu_f(float x) { return __builtin_amdgcn_fmed3f(x, 0.f, 3.0e38f); }

__device__ __forceinline__ unsigned suffix_above(unsigned lane_sum, int lane) {
    const unsigned inc = wave_scan_incl(lane_sum);
    return (unsigned)__builtin_amdgcn_readlane((int)inc, 63) - inc;
}
__device__ __forceinline__ void find_bin(const LAS unsigned* hist, int lane, unsigned need, unsigned& bin, unsigned& above) {
    const u32x4 c = *(const LAS u32x4*)(hist + 4 * lane);
    const unsigned ls = c.x + c.y + c.z + c.w;
    const unsigned ab3 = suffix_above(ls, lane);
    const unsigned ab2 = ab3 + c.w, ab1 = ab2 + c.z, ab0 = ab1 + c.y;
    unsigned mybin = 0xffffffffu, myab = 0;
    if (ab3 < need && need <= ab3 + c.w) { mybin = 4 * lane + 3; myab = ab3; }
    else if (ab2 < need && need <= ab2 + c.z) { mybin = 4 * lane + 2; myab = ab2; }
    else if (ab1 < need && need <= ab1 + c.y) { mybin = 4 * lane + 1; myab = ab1; }
    else if (ab0 < need && need <= ab0 + c.x) { mybin = 4 * lane + 0; myab = ab0; }
    const unsigned long long bal = __ballot(mybin != 0xffffffffu);
    const int src = bal ? (int)__builtin_ctzll(bal) : 0;
    bin = (unsigned)__builtin_amdgcn_readlane((int)mybin, src); above = (unsigned)__builtin_amdgcn_readlane((int)myab, src);
}

#define TR8(o0, o1, o2, o3, o4, o5, o6, o7, alo, ahi, F0, F1, F2, F3) \
    asm volatile("ds_read_b64_tr_b16 %0, %8 offset:" #F0 "\n\tds_read_b64_tr_b16 %1, %9 offset:" #F0 "\n\t" \
                 "ds_read_b64_tr_b16 %2, %8 offset:" #F1 "\n\tds_read_b64_tr_b16 %3, %9 offset:" #F1 "\n\t" \
                 "ds_read_b64_tr_b16 %4, %8 offset:" #F2 "\n\tds_read_b64_tr_b16 %5, %9 offset:" #F2 "\n\t" \
                 "ds_read_b64_tr_b16 %6, %8 offset:" #F3 "\n\tds_read_b64_tr_b16 %7, %9 offset:" #F3 "\n\ts_waitcnt lgkmcnt(0)" \
                 : "=&v"(o0), "=&v"(o1), "=&v"(o2), "=&v"(o3), "=&v"(o4), "=&v"(o5), "=&v"(o6), "=&v"(o7) : "v"(alo), "v"(ahi) : "memory")

__device__ __forceinline__ void p4_attn_item(LAS unsigned char* lds, LAS unsigned short* idxl  , bf16_t* __restrict__ P, const bf16_t* __restrict__ CKV, const bf16_t* __restrict__ KIX, const float* __restrict__ WIX,
                                             int b, int item, int tid, GBar& gb) {
    const int lane = tid & 63, wave = __builtin_amdgcn_readfirstlane(tid >> 6), w4 = wave & 3, m = lane & 15, g = lane >> 4;
    const int c = 127 - (item >> 4), sub = item & 15;
    const int limit = 64 * (c + 1), q0 = b * SEQ + c * 64 + sub * 4;
    const int nsel = limit < 256 ? limit : 256;
    LAS unsigned* qmaxl = (LAS unsigned*)(idxl + 8 * 256) + (wave >> 2) * 16;
    LAS unsigned short* myidx = idxl + wave * 256;
    if (limit > 256) {
        bf16x8 aq[2]; f32x4 wq;
        { const int q = m >> 2, hh = m & 3;
#pragma unroll
          for (int ks = 0; ks < 2; ++ks) aq[ks] = *(const bf16x8*)(P + (size_t)(q0 + q) * NP + PC_QIX + hh * 64 + 32 * ks + 8 * g);
          wq = *(const f32x4*)(WIX + (size_t)(q0 + g) * 4); }
        const bf16_t* kb = KIX + (size_t)b * SEQ * 64;
        const int ntile = limit / 16, ni = (ntile - w4 + 3) >> 2, ng = (ni + 3) >> 2;
        bf16x8 kA0[4], kA1[4], kB0[4], kB1[4]; unsigned mk = 0u;
#define SC_TILE(r0, r1, u, kt) do { \
                f32x4 acc = (f32x4){0.f, 0.f, 0.f, 0.f}; \
                acc = __builtin_amdgcn_mfma_f32_16x16x32_bf16(aq[0], r0[u], acc, 0, 0, 0); \
                acc = __builtin_amdgcn_mfma_f32_16x16x32_bf16(aq[1], r1[u], acc, 0, 0, 0); \
                const float sv = wq[0] * relu_f(acc[0]) + wq[1] * relu_f(acc[1]) + wq[2] * relu_f(acc[2]) + wq[3] * relu_f(acc[3]); \
                const unsigned key = score_key(sv); mk = key > mk ? key : mk; \
                *(LAS unsigned short*)(lds + AT_SC + g * AT_RS + (16 * (kt) + m) * 2) = (unsigned short)key; } while (0)
#define SC_LOAD(r0, r1, gi_) do { _Pragma("unroll") for (int u = 0; u < 4; ++u) { const int i_ = (gi_) * 4 + u; if (i_ < ni) { const bf16_t* kp = kb + (size_t)(w4 + 4 * i_) * 1024 + lane * 8; r0[u] = *(const bf16x8*)kp; r1[u] = *(const bf16x8*)(kp + 512); } } } while (0)
#define SC_COMP(r0, r1, gi_) do { _Pragma("unroll") for (int u = 0; u < 4; ++u) { const int i_ = (gi_) * 4 + u; if (i_ < ni) { SC_TILE(r0, r1, u, w4 + 4 * i_); } } } while (0)
#define SC_LOAD_F(r0, r1, gi_) do { _Pragma("unroll") for (int u = 0; u < 4; ++u) { const bf16_t* kp = kb + (size_t)(w4 + 4 * ((gi_) * 4 + u)) * 1024 + lane * 8; r0[u] = *(const bf16x8*)kp; r1[u] = *(const bf16x8*)(kp + 512); } } while (0)
#define SC_COMP_F(r0, r1, gi_) do { _Pragma("unroll") for (int u = 0; u < 4; ++u) { SC_TILE(r0, r1, u, w4 + 4 * ((gi_) * 4 + u)); } } while (0)
        const int ngf = ni >> 2;
        if (ngf > 0) SC_LOAD_F(kA0, kA1, 0);
        int gi = 0;
        for (; gi + 1 < ngf; gi += 2) {
            SC_LOAD_F(kB0, kB1, gi + 1);
            SC_COMP_F(kA0, kA1, gi);
            if (gi + 2 < ngf) SC_LOAD_F(kA0, kA1, gi + 2);
            SC_COMP_F(kB0, kB1, gi + 1);
        }
        if (gi < ngf) { SC_COMP_F(kA0, kA1, gi); ++gi; }
        if (gi < ng) { SC_LOAD(kB0, kB1, gi); SC_COMP(kB0, kB1, gi); }
#undef SC_LOAD
#undef SC_COMP
#undef SC_LOAD_F
#undef SC_COMP_F
#undef SC_TILE
        { const unsigned v = row16_max_u(mk); if (m == 0) qmaxl[w4 * 4 + g] = v; }
        gbar_sync(gb, lane);
        {
            LAS unsigned* hist = (LAS unsigned*)(lds + AT_HIST) + w4 * 512;
            const LAS unsigned char* ms = lds + AT_SC + w4 * AT_RS;
            unsigned kmax = 0;
#pragma unroll
            for (int w = 0; w < 4; ++w) { const unsigned t = qmaxl[w * 4 + w4]; kmax = t > kmax ? t : kmax; }
#define KEY_E(v, e) (((e) & 1) ? ((v)[(e) >> 1] >> 16) : ((v)[(e) >> 1] & 0xffffu))
            unsigned T = 0, cnt_gt = 0;
            for (unsigned base = kmax, above = 0;;) {
                *(LAS u32x4*)(hist + 8 * lane) = (u32x4){0u, 0u, 0u, 0u}; *(LAS u32x4*)(hist + 8 * lane + 4) = (u32x4){0u, 0u, 0u, 0u};
                for (int i0 = 0; i0 < limit; i0 += 512) {
                    const u32x4 v = *(const LAS u32x4*)(ms + (i0 + lane * 8) * 2); const bool lv = i0 + lane * 8 < limit;
#pragma unroll
                    for (int e = 0; e < 8; ++e) { const unsigned d = base - KEY_E(v, e); if (lv && d < AT_WIN) __hip_atomic_fetch_add(hist + d, 1u, __ATOMIC_RELAXED, __HIP_MEMORY_SCOPE_WORKGROUP); }
                }
                const unsigned need = 256u - above;
                const u32x4 c0 = *(const LAS u32x4*)(hist + 8 * lane), c1 = *(const LAS u32x4*)(hist + 8 * lane + 4);
                const unsigned cw[8] = {c0.x, c0.y, c0.z, c0.w, c1.x, c1.y, c1.z, c1.w};
                const unsigned ls = (c0.x + c0.y) + (c0.z + c0.w) + (c1.x + c1.y) + (c1.z + c1.w), inc = wave_scan_incl(ls);
                const unsigned tot = (unsigned)__builtin_amdgcn_readlane((int)inc, 63);
                if (tot >= need) {
                    unsigned run = inc - ls, mybin = 0xffffffffu, myab = 0;
#pragma unroll
                    for (int j = 0; j < 8; ++j) { if (run < need && need <= run + cw[j]) { mybin = 8 * lane + j; myab = run; } run += cw[j]; }
                    const unsigned long long bal = __ballot(mybin != 0xffffffffu); const int src = (int)__builtin_ctzll(bal);
                    T = base - (unsigned)__builtin_amdgcn_readlane((int)mybin, src); cnt_gt = above + (unsigned)__builtin_amdgcn_readlane((int)myab, src);
                    break;
                }
                above += tot;
                if (base < AT_WIN || base + 0u < kmax) {
                    *(LAS u32x4*)(hist + 4 * lane) = (u32x4){0u, 0u, 0u, 0u};
                    for (int i0 = 0; i0 < limit; i0 += 512) {
                        const u32x4 v = *(const LAS u32x4*)(ms + (i0 + lane * 8) * 2); const bool lv = i0 + lane * 8 < limit;
#pragma unroll
                        for (int e = 0; e < 8; ++e) if (lv) __hip_atomic_fetch_add(hist + (KEY_E(v, e) >> 8), 1u, __ATOMIC_RELAXED, __HIP_MEMORY_SCOPE_WORKGROUP);
                    }
                    unsigned b1, above1; find_bin(hist, lane, 256u, b1, above1);
                    *(LAS u32x4*)(hist + 4 * lane) = (u32x4){0u, 0u, 0u, 0u};
                    for (int i0 = 0; i0 < limit; i0 += 512) {
                        const u32x4 v = *(const LAS u32x4*)(ms + (i0 + lane * 8) * 2); const bool lv = i0 + lane * 8 < limit;
#pragma unroll
                        for (int e = 0; e < 8; ++e) { const unsigned k = KEY_E(v, e); if (lv && (k >> 8) == b1) __hip_atomic_fetch_add(hist + (k & 255u), 1u, __ATOMIC_RELAXED, __HIP_MEMORY_SCOPE_WORKGROUP); }
                    }
                    unsigned b2, above2; find_bin(hist, lane, 256u - above1, b2, above2);
                    T = (b1 << 8) | b2; cnt_gt = above1 + above2;
                    break;
                }
                base -= AT_WIN;
            }
            const unsigned need_eq = 256u - cnt_gt;
            unsigned cur_gt = 0, cur_eq = 0;
#define EMIT_BLOCK(LV) do { \
                const u32x4 v = *(const LAS u32x4*)(ms + (i0 + lane * 8) * 2); \
                unsigned long long anyeq = 0ull; \
                _Pragma("unroll") for (int e = 0; e < 8; ++e) { \
                    const unsigned k = KEY_E(v, e); \
                    const bool gt = (LV) && k > T; \
                    const unsigned long long mg = __ballot(gt); \
                    anyeq |= __ballot((LV) && k == T); \
                    if (gt) myidx[cur_gt + __builtin_amdgcn_mbcnt_hi((unsigned)(mg >> 32), __builtin_amdgcn_mbcnt_lo((unsigned)mg, 0u))] = (unsigned short)(i0 + lane * 8 + e); \
                    cur_gt += __builtin_popcountll(mg); \
                } \
                if (anyeq != 0ull && cur_eq < need_eq) {                              \
                    unsigned eqm = 0; \
                    _Pragma("unroll") for (int e = 0; e < 8; ++e) eqm |= ((LV) && KEY_E(v, e) == T) ? (1u << e) : 0u; \
                    const unsigned ce = __builtin_popcount(eqm); const unsigned inc = wave_scan_incl(ce); \
                    unsigned r = cur_eq + inc - ce; \
                    _Pragma("unroll") for (int e = 0; e < 8; ++e) if (eqm & (1u << e)) { if (r < need_eq) myidx[cnt_gt + r] = (unsigned short)(i0 + lane * 8 + e); ++r; } \
                    cur_eq += (unsigned)__builtin_amdgcn_readlane((int)inc, 63); \
                } } while (0)
            int i0 = 0;
            for (; i0 + 512 <= limit; i0 += 512) EMIT_BLOCK(true);
            if (i0 < limit) EMIT_BLOCK(i0 + lane * 8 < limit);
#undef EMIT_BLOCK
#undef KEY_E
        }
    } else {
        for (int i = lane; i < nsel; i += 64) myidx[i] = (unsigned short)i;
    }
    gbar_sync(gb, lane);
    {
        const int tq = q0 + w4;
        bf16x8 qf[8];
#pragma unroll
        for (int ks = 0; ks < 8; ++ks) { u32x4 z = (u32x4){0u, 0u, 0u, 0u};
            if (m < 4) z = *(const u32x4*)(P + (size_t)tq * NP + PC_QLAT + m * 256 + 32 * ks + 8 * g);
            qf[ks] = __builtin_bit_cast(bf16x8, z); }
        LAS unsigned char* kvs = lds + AT_KV + w4 * AT_KV_WAVE;
        const unsigned tr_lo = (unsigned)(size_t)kvs + (unsigned)((4 * g + (m >> 2)) * 544 + (m & 3) * 8);
        const unsigned tr_hi = tr_lo + 16 * 544;
        f32x4 O[16];
#pragma unroll
        for (int i = 0; i < 16; ++i) O[i] = (f32x4){0.f, 0.f, 0.f, 0.f};
        float mrun = -1e30f, lrun = 0.f;
        const bf16_t* cb = CKV + (size_t)b * SEQ * 256;
        bf16x8 kr[16];
        const int rsel = lane >> 5, rpc = (lane & 31) * 8;
#define AT_LOADK(st_) do { _Pragma("unroll") for (int i_ = 0; i_ < 16; ++i_) { const int kidx = myidx[32 * (st_) + 2 * i_ + rsel]; kr[i_] = *(const bf16x8*)(cb + (size_t)kidx * 256 + rpc); } } while (0)
        AT_LOADK(0);
        const int nst = nsel / 32;
        for (int st = 0; st < nst; ++st) {
#pragma unroll
            for (int i_ = 0; i_ < 16; ++i_) *(LAS bf16x8*)(kvs + (2 * i_ + rsel) * 544 + rpc * 2) = kr[i_];
            asm volatile("s_waitcnt lgkmcnt(0)" ::: "memory");
            if (st + 1 < nst) AT_LOADK(st + 1);
            f32x4 s[2];
#pragma unroll
            for (int mt = 0; mt < 2; ++mt) { s[mt] = (f32x4){0.f, 0.f, 0.f, 0.f};
#pragma unroll
                for (int ks = 0; ks < 8; ++ks) { const bf16x8 kfr = *(const LAS bf16x8*)(kvs + (16 * mt + m) * 544 + (32 * ks + 8 * g) * 2); s[mt] = __builtin_amdgcn_mfma_f32_16x16x32_bf16(kfr, qf[ks], s[mt], 0, 0, 0); } }
            float mx = -1e30f;
#pragma unroll
            for (int mt = 0; mt < 2; ++mt)
#pragma unroll
                for (int jj = 0; jj < 4; ++jj) mx = fmaxf(mx, s[mt][jj]);
            mx = xrow_max(mx);
            constexpr float SM_C = SM_SCALE * 1.4426950408889634f;
            const float mnew = fmaxf(mrun, mx), alpha = __builtin_amdgcn_exp2f((mrun - mnew) * SM_C), mc = -mnew * SM_C;
            float ps = 0.f; float p[2][4];
#pragma unroll
            for (int mt = 0; mt < 2; ++mt)
#pragma unroll
                for (int jj = 0; jj < 4; ++jj) { p[mt][jj] = __builtin_amdgcn_exp2f(__builtin_fmaf(s[mt][jj], SM_C, mc)); ps += p[mt][jj]; }
            lrun = lrun * alpha + ps; mrun = mnew;
            u32x4 pw; pw.x = cvt_pk_bf16(p[0][0], p[0][1]); pw.y = cvt_pk_bf16(p[0][2], p[0][3]); pw.z = cvt_pk_bf16(p[1][0], p[1][1]); pw.w = cvt_pk_bf16(p[1][2], p[1][3]);
            const bf16x8 pb = __builtin_bit_cast(bf16x8, pw);
            if (st > 0 && __ballot(alpha != 1.0f) != 0ull) {
#pragma unroll
            for (int i = 0; i < 16; ++i) O[i] *= alpha; }
            asm volatile("s_waitcnt lgkmcnt(0)" ::: "memory");
#define AT_PV2(dt0, F0, F1, F2, F3, F4, F5, F6, F7) do { bf16x4 l0, h0, l1, h1, l2, h2, l3, h3, l4, h4, l5, h5, l6, h6, l7, h7; \
            asm volatile("ds_read_b64_tr_b16 %0, %16 offset:" #F0 "\n\tds_read_b64_tr_b16 %1, %17 offset:" #F0 "\n\tds_read_b64_tr_b16 %2, %16 offset:" #F1 "\n\tds_read_b64_tr_b16 %3, %17 offset:" #F1 "\n\t" \
                         "ds_read_b64_tr_b16 %4, %16 offset:" #F2 "\n\tds_read_b64_tr_b16 %5, %17 offset:" #F2 "\n\tds_read_b64_tr_b16 %6, %16 offset:" #F3 "\n\tds_read_b64_tr_b16 %7, %17 offset:" #F3 "\n\t" \
                         "ds_read_b64_tr_b16 %8, %16 offset:" #F4 "\n\tds_read_b64_tr_b16 %9, %17 offset:" #F4 "\n\tds_read_b64_tr_b16 %10, %16 offset:" #F5 "\n\tds_read_b64_tr_b16 %11, %17 offset:" #F5 "\n\t" \
                         "ds_read_b64_tr_b16 %12, %16 offset:" #F6 "\n\tds_read_b64_tr_b16 %13, %17 offset:" #F6 "\n\tds_read_b64_tr_b16 %14, %16 offset:" #F7 "\n\tds_read_b64_tr_b16 %15, %17 offset:" #F7 "\n\ts_waitcnt lgkmcnt(8)" \
                         : "=&v"(l0), "=&v"(h0), "=&v"(l1), "=&v"(h1), "=&v"(l2), "=&v"(h2), "=&v"(l3), "=&v"(h3), "=&v"(l4), "=&v"(h4), "=&v"(l5), "=&v"(h5), "=&v"(l6), "=&v"(h6), "=&v"(l7), "=&v"(h7) \
                         : "v"(tr_lo), "v"(tr_hi) : "memory"); \
            O[dt0 + 0] = __builtin_amdgcn_mfma_f32_16x16x32_bf16(__builtin_shufflevector(l0, h0, 0, 1, 2, 3, 4, 5, 6, 7), pb, O[dt0 + 0], 0, 0, 0); \
            O[dt0 + 1] = __builtin_amdgcn_mfma_f32_16x16x32_bf16(__builtin_shufflevector(l1, h1, 0, 1, 2, 3, 4, 5, 6, 7), pb, O[dt0 + 1], 0, 0, 0); \
            O[dt0 + 2] = __builtin_amdgcn_mfma_f32_16x16x32_bf16(__builtin_shufflevector(l2, h2, 0, 1, 2, 3, 4, 5, 6, 7), pb, O[dt0 + 2], 0, 0, 0); \
            O[dt0 + 3] = __builtin_amdgcn_mfma_f32_16x16x32_bf16(__builtin_shufflevector(l3, h3, 0, 1, 2, 3, 4, 5, 6, 7), pb, O[dt0 + 3], 0, 0, 0); \
            asm volatile("s_waitcnt lgkmcnt(0)" : "+v"(l4), "+v"(h4), "+v"(l5), "+v"(h5), "+v"(l6), "+v"(h6), "+v"(l7), "+v"(h7) :: "memory"); \
            O[dt0 + 4] = __builtin_amdgcn_mfma_f32_16x16x32_bf16(__builtin_shufflevector(l4, h4, 0, 1, 2, 3, 4, 5, 6, 7), pb, O[dt0 + 4], 0, 0, 0); \
            O[dt0 + 5] = __builtin_amdgcn_mfma_f32_16x16x32_bf16(__builtin_shufflevector(l5, h5, 0, 1, 2, 3, 4, 5, 6, 7), pb, O[dt0 + 5], 0, 0, 0); \
            O[dt0 + 6] = __builtin_amdgcn_mfma_f32_16x16x32_bf16(__builtin_shufflevector(l6, h6, 0, 1, 2, 3, 4, 5, 6, 7), pb, O[dt0 + 6], 0, 0, 0); \
            O[dt0 + 7] = __builtin_amdgcn_mfma_f32_16x16x32_bf16(__builtin_shufflevector(l7, h7, 0, 1, 2, 3, 4, 5, 6, 7), pb, O[dt0 + 7], 0, 0, 0); } while (0)
            AT_PV2(0, 0, 32, 64, 96, 128, 160, 192, 224); AT_PV2(8, 256, 288, 320, 352, 384, 416, 448, 480);
#undef AT_PV2
        }
#undef AT_LOADK
        const float inv = __builtin_amdgcn_rcpf(xrow_sum(lrun));
        if (m < 4) {
            bf16_t* op = P + (size_t)tq * NP + 512 + m * 256 + 4 * g;
#pragma unroll
            for (int dt = 0; dt < 16; ++dt) { u32x2 w; w.x = cvt_pk_bf16(O[dt][0] * inv, O[dt][1] * inv); w.y = cvt_pk_bf16(O[dt][2] * inv, O[dt][3] * inv); *(u32x2*)(op + 16 * dt) = w; }
        }
    }
    gbar_sync(gb, lane);
}

constexpr int P6_W = 8192, P6_WS = 272  , P6_WHALF = 64 * P6_WS, P6_H = P6_W + 2 * P6_WHALF, P6_HS = 272, P6_HHALF = 16 * P6_HS, P6_HW = 2 * P6_HHALF > 16 * 64 * 4 ? 2 * P6_HHALF : 16 * 64 * 4;
static_assert(P6_H + 8 * P6_HW <= LDS_MAIN_BYTES, "phase 6 LDS");
__device__ __forceinline__ void p6_norm_route(LAS unsigned char* lds, const bf16_t* __restrict__ X1, const float* __restrict__ gain, const float* __restrict__ modp, const float* __restrict__ ada_b,
                                              const float* __restrict__ rw, const float* __restrict__ rb, bf16_t* __restrict__ H2, unsigned char* __restrict__ tab, int blk, int nblk, int tid) {
    const int wave = __builtin_amdgcn_readfirstlane(tid >> 6), lane = tid & 63, m = lane & 15, g = lane >> 4;
    LAS float* sm = (LAS float*)lds;
    LAS unsigned char* Wl = lds + P6_W;
    LAS unsigned char* hwb = lds + P6_H + wave * P6_HW;
    LAS float* hw = (LAS float*)hwb;
    LAS int* cntw = (LAS int*)(lds + LDS_AUX);
    int* RTE = (int*)(tab + T_RTE); float* RTG = (float*)(tab + T_RTG); int* CNT = (int*)(tab + T_CNT);
    const float rbias = rb[lane];
    for (int tb = blk; tb < NTOK / 128; tb += nblk) {
        const int b = (tb * 128) / SEQ;
        const size_t row0 = (size_t)tb * 128 + wave * 16;
        __syncthreads();
        load_mod(sm, modp, ada_b, b, 3072, 2048, tid);
        float rstd[16];
#pragma unroll
        for (int r4 = 0; r4 < 16; r4 += 4) {
            f32x4 v[4][4];
#pragma unroll
            for (int rr = 0; rr < 4; ++rr)
#pragma unroll
                for (int i = 0; i < 4; ++i) { const u32x2 w = *(const u32x2*)(X1 + (size_t)(row0 + r4 + rr) * XB_LD + i * 256 + lane * 4); v[rr][i] = (f32x4){bflo(w.x), bfhi(w.x), bflo(w.y), bfhi(w.y)}; }
#pragma unroll
            for (int rr = 0; rr < 4; ++rr) { float ss = 0.f;
#pragma unroll
                for (int i = 0; i < 4; ++i) ss += v[rr][i][0] * v[rr][i][0] + v[rr][i][1] * v[rr][i][1] + v[rr][i][2] * v[rr][i][2] + v[rr][i][3] * v[rr][i][3];
                rstd[r4 + rr] = rsqrtf(wave_sum(ss) * (1.0f / DM) + EPS); }
        }
        f32x4 acc[4];
#pragma unroll
        for (int nt = 0; nt < 4; ++nt) acc[nt] = (f32x4){0.f, 0.f, 0.f, 0.f};
        const int wr_ = tid >> 2, pc = (tid & 3) * 16;
        f32x4 wvn[4]; unsigned xwn[16]; f32x2 gvn;
#define P6_FETCH(kc_) do { const float* src_ = rw + (size_t)((kc_) * 128 + wr_) * 64 + pc; _Pragma("unroll") for (int i = 0; i < 4; ++i) wvn[i] = *(const f32x4*)(src_ + 4 * i); \
            const int cn_ = (kc_) * 128 + lane * 2; gvn = *(const f32x2*)(gain + cn_); \
            _Pragma("unroll") for (int r = 0; r < 16; ++r) xwn[r] = *(const unsigned*)(X1 + (size_t)(row0 + r) * XB_LD + cn_); } while (0)
        P6_FETCH(0);
        for (int kc = 0; kc < 8; ++kc) {
            __syncthreads();
            {
#pragma unroll
              for (int i = 0; i < 4; ++i) { const f32x4 wv = wvn[i];
#pragma unroll
                  for (int j = 0; j < 4; ++j) { const bf16_t hi = f2bf(wv[j]); const bf16_t lo = f2bf(wv[j] - bf2f(hi)); const int n = pc + 4 * i + j;
                      *(LAS bf16_t*)(Wl + n * P6_WS + wr_ * 2) = hi; *(LAS bf16_t*)(Wl + P6_WHALF + n * P6_WS + wr_ * 2) = lo; } } }
            const int c0 = kc * 128 + lane * 2;
            const f32x2 gv = gvn;
            const float sh0 = sm[c0], sh1 = sm[c0 + 1], sc0 = 1.0f + sm[1024 + c0], sc1 = 1.0f + sm[1024 + c0 + 1];
            f32x2 xv[16];
#pragma unroll
            for (int r = 0; r < 16; ++r) xv[r] = (f32x2){bflo(xwn[r]), bfhi(xwn[r])};
            if (kc + 1 < 8) P6_FETCH(kc + 1);
#pragma unroll
            for (int r = 0; r < 16; ++r) { const float h0 = xv[r][0] * rstd[r] * gv[0] * sc0 + sh0, h1 = xv[r][1] * rstd[r] * gv[1] * sc1 + sh1;
                const unsigned hi = cvt_pk_bf16(h0, h1);
                const unsigned lo = cvt_pk_bf16(h0 - bflo(hi), h1 - bfhi(hi));
                *(LAS unsigned*)(hwb + r * P6_HS + lane * 4) = hi; *(LAS unsigned*)(hwb + P6_HHALF + r * P6_HS + lane * 4) = lo;
                *(unsigned*)(H2 + (row0 + r) * DM + c0) = hi; }
            __syncthreads();
#pragma unroll
            for (int ks = 0; ks < 4; ++ks) {
                const bf16x8 ahi = *(const LAS bf16x8*)(hwb + m * P6_HS + (32 * ks + 8 * g) * 2), alo = *(const LAS bf16x8*)(hwb + P6_HHALF + m * P6_HS + (32 * ks + 8 * g) * 2);
#pragma unroll
                for (int nt = 0; nt < 4; ++nt) {
                    const bf16x8 bhi = *(const LAS bf16x8*)(Wl + (16 * nt + m) * P6_WS + (32 * ks + 8 * g) * 2), blo = *(const LAS bf16x8*)(Wl + P6_WHALF + (16 * nt + m) * P6_WS + (32 * ks + 8 * g) * 2);
                    acc[nt] = __builtin_amdgcn_mfma_f32_16x16x32_bf16(ahi, bhi, acc[nt], 0, 0, 0);
                    acc[nt] = __builtin_amdgcn_mfma_f32_16x16x32_bf16(ahi, blo, acc[nt], 0, 0, 0);
                    acc[nt] = __builtin_amdgcn_mfma_f32_16x16x32_bf16(alo, bhi, acc[nt], 0, 0, 0);
                }
            }
        }
#undef P6_FETCH
#pragma unroll
        for (int nt = 0; nt < 4; ++nt)
#pragma unroll
            for (int j = 0; j < 4; ++j) hw[(4 * g + j) * 64 + 16 * nt + m] = acc[nt][j];
        int mycnt = 0;
        for (int r = 0; r < 16; ++r) {
            const size_t row = row0 + r;
            const float lg = hw[r * 64 + lane];
            const float s = sigmoid_f(lg), ch = s + rbias;
            float m1 = oct_max(ch);
            const unsigned long long bm = __ballot(ch == m1);
            const unsigned gm = (unsigned)((bm >> (lane & 56)) & 0xffull);
            const int first = __builtin_ctz(gm);
            float m2 = oct_max(((lane & 7) == first) ? -INFINITY : ch);
            const float gs = m1 + m2;
            int grank = 0; const int myg = lane >> 3;
#pragma unroll
            for (int g2 = 0; g2 < 8; ++g2) { const float o = __builtin_bit_cast(float, __builtin_amdgcn_readlane(__builtin_bit_cast(int, gs), g2 * 8)); grank += (o > gs || (o == gs && g2 < myg)) ? 1 : 0; }
            const float mc = grank < 4 ? ch : -INFINITY;
            unsigned long long selm = 0ull; float mcw = mc;
#pragma unroll
            for (int it = 0; it < 8; ++it) {
                const float mxr = xrow_max(row16_max_f(mcw));
                const unsigned long long bmx = __ballot(mcw == mxr) & ~selm;
                const unsigned long long pick = bmx & (0ull - bmx);
                selm |= pick;
                mcw = ((pick >> lane) & 1ull) ? -INFINITY : mcw;
            }
            const bool sel = (selm >> lane) & 1ull;
            float gsum = sel ? s : 0.f; gsum = wave_sum(gsum);
            const unsigned long long sb = __ballot(sel);
            const int slot = __builtin_popcountll(sb & ((1ull << lane) - 1ull));
            if (sel && slot < 8) { RTE[row * 8 + slot] = lane; RTG[row * 8 + slot] = s * __builtin_amdgcn_rcpf(gsum) * 2.5f; mycnt += 1; }
        }
        cntw[wave * 64 + lane] = mycnt;
        __syncthreads();
        if (tid < 64) { int c = 0;
#pragma unroll
            for (int w = 0; w < 8; ++w) c += cntw[w * 64 + tid];
            CNT[tid * 256 + tb] = c; }
    }
    __syncthreads();
}

__device__ __forceinline__ void p7_place(LAS unsigned char* lds, unsigned char* __restrict__ tab, int blk, int nblk, int tid) {
    const int wave = tid >> 6, lane = tid & 63;
    const int* RTE = (const int*)(tab + T_RTE); const float* RTG = (const float*)(tab + T_RTG); const int* CNT = (const int*)(tab + T_CNT);
    int* STOK = (int*)(tab + T_STOK); float* SGATE = (float*)(tab + T_SGATE); int* OFFS = (int*)(tab + T_OFFS); int* TILE = (int*)(tab + T_TILE); int* META = (int*)(tab + T_META); int* POS = (int*)(tab + T_POS);
    LAS int* tot = (LAS int*)lds; LAS int* pre = tot + 64; LAS int* base = tot + 128; LAS int* le = tot + 256; LAS float* lg = (LAS float*)(tot + 256 + 1024); LAS unsigned* emask = (LAS unsigned*)(tot + 256 + 2048);
    for (int tb = blk; tb < NTOK / 128; tb += nblk) {
        __syncthreads();
        for (int e = wave * 8; e < wave * 8 + 8; ++e) { int t = 0, p = 0;
#pragma unroll
            for (int i = 0; i < 4; ++i) { const int j = lane + 64 * i; const int c = CNT[e * 256 + j]; t += c; p += (j < tb) ? c : 0; }
            t = __builtin_amdgcn_readlane((int)wave_scan_incl((unsigned)t), 63); p = __builtin_amdgcn_readlane((int)wave_scan_incl((unsigned)p), 63);
            if (lane == 0) { tot[e] = t; pre[e] = p; } }
        for (int i = tid; i < 1024; i += NTHREADS) { le[i] = RTE[(size_t)tb * 1024 + i]; lg[i] = RTG[(size_t)tb * 1024 + i]; }
        __syncthreads();
        if (tid == 0) { int acc = 0; for (int e = 0; e < 64; ++e) { base[e] = acc; acc += (tot[e] + 255) & ~255; } base[64] = acc; }
        __syncthreads();
        if (tid < 64) { const int e = tid; OFFS[e * 257 + tb] = base[e] + pre[e]; if (tb == NTOK / 128 - 1) OFFS[e * 257 + 256] = base[e] + tot[e]; }
        for (int i = tid; i < 256; i += NTHREADS) emask[i] = 0u;
        __syncthreads();
        for (int i = tid; i < 1024; i += NTHREADS) { const int tl = i >> 3; __hip_atomic_fetch_or(emask + le[i] * 4 + (tl >> 5), 1u << (tl & 31), __ATOMIC_RELAXED, __HIP_MEMORY_SCOPE_WORKGROUP); }
        __syncthreads();
        for (int i = tid; i < 1024; i += NTHREADS) {
            const int e = le[i], tl = i >> 3, wq = tl >> 5; const LAS unsigned* mk = emask + e * 4;
            int rank = __builtin_popcount(mk[wq] & ((1u << (tl & 31)) - 1u));
            rank += (wq > 0 ? __builtin_popcount(mk[0]) : 0) + (wq > 1 ? __builtin_popcount(mk[1]) : 0) + (wq > 2 ? __builtin_popcount(mk[2]) : 0);
            const int pos = base[e] + pre[e] + rank;
            STOK[pos] = tb * 128 + tl; SGATE[pos] = lg[i]; POS[(size_t)tb * 1024 + i] = pos;
        }
        for (int e = tb; e < 64; e += NTOK / 128) { const int r0 = base[e] + tot[e], r1 = base[e] + ((tot[e] + 255) & ~255);
            for (int r = r0 + tid; r < r1; r += NTHREADS) { STOK[r] = 0; SGATE[r] = 0.f; } }
        const int R0 = base[64];
        for (int t = tb * 128 + tid; t < tb * 128 + 128; t += NTHREADS) { STOK[R0 + t] = t; SGATE[R0 + t] = 1.0f; }
        if (tb == 0) {
            const int ntile = R0 / 256 + NTOK / 256;
            for (int pm = tid; pm < ntile; pm += NTHREADS) { int e = 64; if (pm < R0 / 256) { e = 0; while (e < 63 && pm * 256 >= base[e + 1]) ++e; } TILE[pm] = e; }
            if (tid == 0) { META[0] = ntile; META[1] = R0; }
        }
    }
    __syncthreads();
}

template <bool FINAL>
__device__ __forceinline__ void p_combine(const unsigned char* __restrict__ Y, const unsigned char* __restrict__ tab, const float* __restrict__ gt2, float* X1, const float* __restrict__ fgain,
                                          int gwave, int nwaves, int lane) {
    const int* POS = (const int*)(tab + T_POS); const float* RTG = (const float*)(tab + T_RTG); const int R0 = ((const int*)(tab + T_META))[1];
    const int half = FINAL ? 1 : 0, c0 = half * 512 + lane * 8;
    int pn[8]; float gn[8], gc[8];
    u32x2 yw[9]; float ysc[9]; u32x4 xw, lw;
#define CB_LOADPG(tok) do { _Pragma("unroll") for (int k = 0; k < 8; ++k) { pn[k] = POS[(size_t)(tok) * 8 + k]; gn[k] = RTG[(size_t)(tok) * 8 + k]; } } while (0)
#define CB_LOADY(tok) do { _Pragma("unroll") for (int k = 0; k < 9; ++k) { const unsigned char* yr = Y + (size_t)(k < 8 ? pn[k] : R0 + (tok)) * Y_LD; yw[k] = *(const u32x2*)(yr + lane * 8); ysc[k] = *(const float*)(yr + Y_SC + 4 * (lane >> 2)); } \
        { const bf16_t* xb_ = (const bf16_t*)X1 + (size_t)(tok) * XB_LD; xw = *(const u32x4*)(xb_ + c0); if (FINAL) lw = *(const u32x4*)(xb_ + XB_X2 + lane * 8); } \
        _Pragma("unroll") for (int k = 0; k < 8; ++k) gc[k] = gn[k]; } while (0)
    int t = gwave;
    if (t >= NTOK) return;
    lw = (u32x4){0u, 0u, 0u, 0u};
    CB_LOADPG(t); CB_LOADY(t);
    { const int tn = t + nwaves < NTOK ? t + nwaves : t; CB_LOADPG(tn); }
    for (; t < NTOK; t += nwaves) {
        const int b = t / SEQ;
        u32x2 cw[9]; float cs[9];
#pragma unroll
        for (int k = 0; k < 9; ++k) { cw[k] = yw[k]; cs[k] = ysc[k] * (k < 8 ? gc[k] : 1.0f); }
        const u32x4 cxw = xw, clw = lw;
        if (t + nwaves < NTOK) { CB_LOADY(t + nwaves); const int tn = t + 2 * nwaves < NTOK ? t + 2 * nwaves : t + nwaves; CB_LOADPG(tn); }
        float v[8];
#pragma unroll
        for (int j = 0; j < 8; ++j) v[j] = 0.f;
#pragma unroll
        for (int k = 0; k < 9; ++k) { const float gq = cs[k];
            const f32x2 p0 = __builtin_amdgcn_cvt_pk_f32_fp8((int)cw[k].x, false), p1 = __builtin_amdgcn_cvt_pk_f32_fp8((int)cw[k].x, true), p2 = __builtin_amdgcn_cvt_pk_f32_fp8((int)cw[k].y, false), p3 = __builtin_amdgcn_cvt_pk_f32_fp8((int)cw[k].y, true);
            v[0] += gq * p0[0]; v[1] += gq * p0[1]; v[2] += gq * p1[0]; v[3] += gq * p1[1]; v[4] += gq * p2[0]; v[5] += gq * p2[1]; v[6] += gq * p3[0]; v[7] += gq * p3[1]; }
        const float* gp = gt2 + (size_t)b * 6144 + c0;
        float* xp = X1 + (size_t)t * DM + c0;
        bf16_t* xb = (bf16_t*)X1 + (size_t)t * XB_LD;
        f32x4 x0 = (f32x4){bflo(cxw.x), bfhi(cxw.x), bflo(cxw.y), bfhi(cxw.y)}, x1v = (f32x4){bflo(cxw.z), bfhi(cxw.z), bflo(cxw.w), bfhi(cxw.w)};
        const f32x4 g0 = *(const f32x4*)gp, g1 = *(const f32x4*)(gp + 4);
        x0 += g0 * (f32x4){v[0], v[1], v[2], v[3]}; x1v += g1 * (f32x4){v[4], v[5], v[6], v[7]};
        if (!FINAL) { u32x4 ow; ow.x = cvt_pk_bf16(x0[0], x0[1]); ow.y = cvt_pk_bf16(x0[2], x0[3]); ow.z = cvt_pk_bf16(x1v[0], x1v[1]); ow.w = cvt_pk_bf16(x1v[2], x1v[3]); *(u32x4*)(xb + XB_X2 + lane * 8) = ow; }
        else {
            f32x4 l0 = (f32x4){bflo(clw.x), bfhi(clw.x), bflo(clw.y), bfhi(clw.y)}, l1 = (f32x4){bflo(clw.z), bfhi(clw.z), bflo(clw.w), bfhi(clw.w)};
            float ss = 0.f;
#pragma unroll
            for (int j = 0; j < 4; ++j) ss += x0[j] * x0[j] + x1v[j] * x1v[j] + l0[j] * l0[j] + l1[j] * l1[j];
            ss = wave_sum(ss);
            const float rstd = rsqrtf(ss * (1.0f / DM) + EPS);
            const f32x4 fa = *(const f32x4*)(fgain + lane * 8), fb = *(const f32x4*)(fgain + lane * 8 + 4), fc = *(const f32x4*)(fgain + c0), fd = *(const f32x4*)(fgain + c0 + 4);
            float* ol = X1 + (size_t)t * DM + lane * 8;
            *(f32x4*)ol = l0 * rstd * fa; *(f32x4*)(ol + 4) = l1 * rstd * fb;
            *(f32x4*)xp = x0 * rstd * fc; *(f32x4*)(xp + 4) = x1v * rstd * fd;
        }
    }
#undef CB_LOADPG
#undef CB_LOADY
}

#define PHASE3_BODY \
        { LAS unsigned* gw = (LAS unsigned*)(lds + LDS_AUX + 4096 + 256); const int half3 = wave >> 2; \
          __syncthreads(); if (tid < 8) gw[tid] = 0u; __syncthreads(); \
          GBar gb{gw + half3, 0u}; \
          if (half3 == 1) p3_token_prep(P, a.in[10], a.in[13], a.in[14], (bf16_t*)(regA + A_CKV), (bf16_t*)(regA + A_KIX), (float*)(regA + A_WIX), gwave, nwaves, lane); \
          for (int pair = blk; pair < 1024; pair += nblk) p3_dn_pair(lds, P, a.in[6], a.in[7], a.in[8], regA, regC, pair, tid, gb); \
          if (half3 == 0) p3_token_prep(P, a.in[10], a.in[13], a.in[14], (bf16_t*)(regA + A_CKV), (bf16_t*)(regA + A_KIX), (float*)(regA + A_WIX), gwave, nwaves, lane); }
#define PHASE4_BODY \
        for (int bh = blk; bh < 16; bh += nblk) p4_dn_scan_fin(lds, P, a.in[9], regA, regC, bh, tid); \
        { LAS unsigned* gw = (LAS unsigned*)(lds + LDS_AUX + 4096 + 256);       \
          const int grp = wave >> 2; \
          __syncthreads(); if (tid < 8) gw[tid] = 0u; __syncthreads(); \
          GBar gb{gw + grp, 0u}; \
          const int hb = (int)(xb_xcc_id() & 3u);       \
          for (;;) { \
            if ((tid & 255) == 0) { unsigned got = 0xffffffffu; for (int k = 0; k < 4; ++k) { const int bb = (hb + k) & 3; const unsigned v = atomicAdd(ctl + CW_QUEUE + 64 * (4 * _rep + bb), 1u); if (v < 2048u) { got = (unsigned)bb * 2048u + v; break; } } gw[4 + grp] = got; } \
            gbar_sync(gb, lane); \
            const unsigned it = (unsigned)__builtin_amdgcn_readfirstlane((int)gw[4 + grp]); if (it == 0xffffffffu) break; \
            p4_attn_item(lds + grp * AT_GRP, (LAS unsigned short*)(lds + LDS_AUX), P, (const bf16_t*)(regA + A_CKV), (const bf16_t*)(regA + A_KIX), (const float*)(regA + A_WIX), (int)(it >> 11), (int)(it & 2047u), tid, gb); } }
#define PHASE5_BODY \
        { pg8::Gemm g{P, WoutT, NTOK, DM, KMIX, NP}; pg8::StaticOrder S; S.init(NTOK, DM, KMIX, WoutT, nblk, blk); pg8::EpiResidual E{x, (bf16_t*)X1, modv + 2048}; \
          pg8::gemm_phase<pg8::EpiResidual, pg8::StaticOrder, false>(lds, g, S, E); }
#define PHASE6_BODY \
        p6_norm_route(lds, (const bf16_t*)X1, a.in[16], modp, a.in[3], a.in[17], a.in[18], H, tab, blk, nblk, tid); \
        p_expert_weights((LAS float*)lds, a.in[19], a.in[20], a.in[21], a.in[22], a.in[23], a.in[24], (bf16_t*)(ws + WS_WGU), (bf16_t*)(ws + WS_WDN), blk, nblk, tid);
#define PHASE7_BODY p7_place(lds, tab, blk, nblk, tid);
#define PHASE8_BODY \
        { const int* META = (const int*)(tab + T_META); \
          pg8::ExpertOrder S{(const int*)(tab + T_TILE), (const int*)(tab + T_STOK), (const bf16_t*)(ws + WS_WGU), 2 * META[0], nblk, blk, (size_t)512 * 1024 * 2, (size_t)256 * 1024 * 2, (size_t)0}; \
          pg8::Gemm g{H, nullptr, 0, 0, 1024, 1024}; pg8::EpiSwiglu E{(bf16_t*)(ws + WS_HB)}; \
          pg8::gemm_phase<pg8::EpiSwiglu, pg8::ExpertOrder, true>(lds, g, S, E); }
#define DOWN_HALF(hf) \
        { const int* META = (const int*)(tab + T_META); \
          pg8::ExpertOrder S{(const int*)(tab + T_TILE), nullptr, (const bf16_t*)(ws + WS_WDN), 2 * META[0], nblk, blk, (size_t)1024 * 256 * 2, (size_t)256 * 256 * 2, (size_t)(hf) * 512 * 256 * 2}; \
          int kd_ = 256; asm volatile("" : "+s"(kd_));       \
          pg8::Gemm g{(const bf16_t*)(ws + WS_HB), nullptr, 0, 0, kd_, 256}; pg8::EpiStoreFp8 E{ws + WS_Y}; \
          pg8::gemm_phase<pg8::EpiStoreFp8, pg8::ExpertOrder, false>(lds, g, S, E); }
#define PHASE9_BODY DOWN_HALF(0)
#define PHASE10_BODY p_combine<false>(ws + WS_Y, tab, modv + 5120, X1, a.in[25], gwave, nwaves, lane);
#define PHASE11_BODY DOWN_HALF(1)
#define PHASE12_BODY p_combine<true>(ws + WS_Y, tab, modv + 5120, X1, a.in[25], gwave, nwaves, lane);
constexpr int N_PHASES = 13;
struct Args { const float* in[26]; float* out; unsigned char* ws; int ph_lo, ph_hi; };
static_assert(sizeof(Args) == 26 * 8 + 8 + 8 + 8, "Args has no padding");

__global__ void __launch_bounds__(NTHREADS, 2) fwd_kernel(Args a) {
    extern __shared__ __attribute__((aligned(16))) unsigned char lds_raw[];
    LAS unsigned char* lds = (LAS unsigned char*)lds_raw;
    const int tid = threadIdx.x, lane = tid & 63, wave = __builtin_amdgcn_readfirstlane(tid >> 6);
    const int blk = blockIdx.x, nblk = gridDim.x, gwave = blk * NWAVES + wave, nwaves = nblk * NWAVES;
    unsigned char* ws = a.ws;
    unsigned* ctl = (unsigned*)(ws + WS_CTL);
    volatile LAS unsigned* misc = (volatile LAS unsigned*)(lds + LDS_MISC);
    if (tid < 64) misc[tid] = 0u;
    __syncthreads();
    const int lo = a.ph_lo, hi = a.ph_hi;
    XcdBarrier bar; bar.bar = ctl + CW_BAR; bar.x = 0; bar.st = misc;
    if (hi - lo > 1) bar = xcd_barrier_post(ctl + CW_BAR, misc);
#define IN(k) (lo <= (k) && (k) < hi)
#define SEAM(k) do { if (IN(k) && IN((k) + 1)) xcd_barrier(bar); } while (0)
#ifndef DUP_PHASE
#define DUP_PHASE -1
#endif
#define REP(k) for (int _rep = 0; _rep < ((DUP_PHASE == (k)) ? 2 : 1); ++_rep)

    const float* x = a.in[0];
    float* modp = (float*)(ws + WS_MODP); float* modv = (float*)(ws + WS_MODV);
    bf16_t* WinT = (bf16_t*)(ws + WS_WINT); bf16_t* WoutT = (bf16_t*)(ws + WS_WOUTT);
    bf16_t* H = (bf16_t*)(ws + WS_A); bf16_t* P = (bf16_t*)(ws + WS_P);
    unsigned char* regA = ws + WS_A; unsigned char* regC = ws + WS_C; unsigned char* tab = ws + WS_TAB;
    float* X1 = a.out;

    if (IN(0)) REP(0) {
        p0_mod_partials((LAS float*)lds, a.in[1], a.in[2], modp, gwave, nwaves, tid);
    }
    SEAM(0);
    if (IN(1)) REP(1) {
        for (int idx = blk * NTHREADS + tid; idx < 4 * 6144; idx += nblk * NTHREADS) { const int b = idx / 6144, col = idx % 6144; float s = a.in[3][col];
#pragma unroll
            for (int ks = 0; ks < 8; ++ks) s += modp[(size_t)(ks * 4 + b) * 6144 + col];
            modv[idx] = s; }
        if ((blk >> 3) & 1) { p0_weights((LAS float*)lds, a.in[5], a.in[11], a.in[12], a.in[15], WinT, WoutT, blk, nblk, tid); __syncthreads(); }
        p1_norm((LAS float*)lds, x, a.in[4], modp, a.in[3], 0, H, blk, nblk, tid);
        if (!((blk >> 3) & 1)) { __syncthreads(); p0_weights((LAS float*)lds, a.in[5], a.in[11], a.in[12], a.in[15], WinT, WoutT, blk, nblk, tid); }
    }
    SEAM(1);
    if (IN(2)) {
#define PHASE2_BODY { pg8::Gemm g{H, WinT, NTOK, NP, 1024, 1024}; pg8::StaticOrder S; S.init(NTOK, NP, 1024, WinT, nblk, blk); pg8::EpiStoreBf16 E{P, NP, PC_Z / 256, PC_Z / 256 + 2}; pg8::gemm_phase<pg8::EpiStoreBf16, pg8::StaticOrder, false>(lds, g, S, E); }
        PHASE2_BODY
        if (DUP_PHASE == 2) { PHASE2_BODY }
    }
    SEAM(2);
    if (IN(3)) REP(3) {
        PHASE3_BODY
    }
    SEAM(3);
    if (IN(4)) REP(4) {
        PHASE4_BODY
    }
    SEAM(4);
    if (IN(5)) {
        PHASE5_BODY
        if (DUP_PHASE == 5) { PHASE5_BODY }
    }
    SEAM(5);
    if (IN(6)) REP(6) {
        PHASE6_BODY
    }
    SEAM(6);
    if (IN(7)) REP(7) {
        PHASE7_BODY
    }
    SEAM(7);
    if (IN(8)) {
        PHASE8_BODY
        if (DUP_PHASE == 8) { PHASE8_BODY }
    }
    SEAM(8);
    if (IN(9)) {
        PHASE9_BODY
        if (DUP_PHASE == 9) { PHASE9_BODY }
    }
    SEAM(9);
    if (IN(10)) {
        PHASE10_BODY
    }
    SEAM(10);
    if (IN(11)) {
        PHASE11_BODY
    }
    SEAM(11);
    if (IN(12)) {
        PHASE12_BODY
    }
#undef IN
#undef SEAM
}

extern "C" void kernel_launch(void* const* d_in, const int* in_sizes, int n_in, void* d_out, int out_size, void* d_ws, size_t ws_size, hipStream_t stream) {
    static int grid = 0;
    if (grid == 0) {
        if (n_in != 26 || out_size != NTOK * DM || ws_size < WS_END || ws_size < WS_TAB + T_END) { fprintf(stderr, "kernel_launch: unexpected shapes (n_in %d out %d ws %zu need %zu)\n", n_in, out_size, ws_size, (size_t)WS_END); grid = -1; return; }
        int dev = 0, cus = 0, per_cu = 0;
        if (hipGetDevice(&dev) != hipSuccess || hipDeviceGetAttribute(&cus, hipDeviceAttributeMultiprocessorCount, dev) != hipSuccess) { grid = -1; return; }
        if (hipFuncSetAttribute((const void*)fwd_kernel, hipFuncAttributeMaxDynamicSharedMemorySize, LDS_BYTES) != hipSuccess) { fprintf(stderr, "kernel_launch: hipFuncSetAttribute failed\n"); grid = -1; return; }
        if (hipOccupancyMaxActiveBlocksPerMultiprocessor(&per_cu, (const void*)fwd_kernel, NTHREADS, LDS_BYTES) != hipSuccess || per_cu < 1) { fprintf(stderr, "kernel_launch: occupancy query reports %d\n", per_cu); }
        (void)hipGetLastError();
        grid = cus;
    }
    if (grid < 0) return;
    (void)hipMemsetAsync((char*)d_ws + WS_CTL, 0, CTL_BYTES, stream);
    Args a{};
    for (int i = 0; i < 26; ++i) a.in[i] = (const float*)d_in[i];
    a.out = (float*)d_out; a.ws = (unsigned char*)d_ws;
    a.ph_lo = 0; a.ph_hi = N_PHASES;
    hipLaunchKernelGGL(fwd_kernel, dim3(grid), dim3(NTHREADS), LDS_BYTES, stream, a);
}
```
